# Optimizing an MI355X kernel written in HIP

```python
import jax, jax.numpy as jnp
from jax import lax
import numpy as np

D_MODEL = 2048
BATCH = 2
SEQ = 8192
DEPTH = 2
DEC_BATCH = 16
DEC_SEQ = 32
PAST_LEN = 2048

CHUNK = 64
N_EVEN = (DEPTH + 1) // 2
N_ODD = DEPTH // 2
EPS = 1e-6
A_WIDTH = D_MODEL // 2
A_GROUPS = 8
A_GROUP_DIM = A_WIDTH // A_GROUPS
A_BLOCK = 128
B_WIDTH = D_MODEL // 2
POOL_WINDOWS = (2, 4, 8, 16)
B_GROUPS = len(POOL_WINDOWS)
B_GROUP_DIM = B_WIDTH // B_GROUPS
POOL_PAD = max(POOL_WINDOWS) - 1
RET_HEADS = 8
RET_QK_DIM = D_MODEL // RET_HEADS
RET_VW = 2 * D_MODEL
RET_V_DIM = RET_VW // RET_HEADS
ROPE_BASE = 10000.0
D_FF = -(-8 * D_MODEL // (3 * 256)) * 256

kernel_name = 'streaming_gmlp_pool_retention_step'


def _rmsnorm(x, g):
    xf = x.astype(jnp.float32)
    y = xf * lax.rsqrt(jnp.mean(xf * xf, axis=-1, keepdims=True) + EPS)
    return (y * g.astype(jnp.float32)).astype(x.dtype)


def _layernorm(x, g, b):
    xf = x.astype(jnp.float32)
    mu = jnp.mean(xf, axis=-1, keepdims=True)
    xc = xf - mu
    y = xc * lax.rsqrt(jnp.mean(xc * xc, axis=-1, keepdims=True) + EPS)
    return (y * g.astype(jnp.float32) + b.astype(jnp.float32)).astype(x.dtype)


def _ada(c, w, b):
    m = jax.nn.silu(c) @ w + b
    return [t[:, None, :] for t in jnp.split(m, 6, axis=-1)]


def _modulate(h, shift, scale):
    return h * (1 + scale) + shift


def _spatial_gate(u, v, w_s, b_s):
    Bn, S, _ = v.shape
    blk = min(S, A_BLOCK)
    nb = S // blk
    idx = jnp.arange(blk)
    mask = (idx[None, :] // CHUNK) <= (idx[:, None] // CHUNK)
    ws = jnp.where(mask[None], w_s[:, :blk, :blk], 0.0).astype(v.dtype)
    vb = v.reshape(Bn, nb, blk, A_GROUPS, A_GROUP_DIM)
    mixed = jnp.einsum('gts,bnsgc->bntgc', ws, vb) + b_s[:, :blk].T[None, None, :, :, None]
    return u * mixed.reshape(Bn, S, A_WIDTH)


def _pool_mix(xb_ext, start, w_pool, pool_scale):
    L = xb_ext.shape[1] - POOL_PAD
    xf = xb_ext.astype(jnp.float32)
    cs = jnp.cumsum(xf, axis=1)
    cs = jnp.concatenate([jnp.zeros_like(cs[:, :1]), cs], axis=1)
    pos = start + jnp.arange(L)
    outs = []
    for g, w in enumerate(POOL_WINDOWS):
        sl = slice(g * B_GROUP_DIM, (g + 1) * B_GROUP_DIM)
        hi = cs[:, POOL_PAD + 1:POOL_PAD + 1 + L, sl]
        lo = cs[:, POOL_PAD + 1 - w:POOL_PAD + 1 - w + L, sl]
        cnt = jnp.minimum(w, pos + 1).astype(jnp.float32)[None, :, None]
        outs.append((hi - lo) / cnt - xf[:, POOL_PAD:, sl])
    pooled = jnp.stack(outs, axis=2)
    y = jnp.einsum('blgc,gcd->blgd', pooled, w_pool.astype(jnp.float32))
    y = y.reshape(xb_ext.shape[0], L, B_WIDTH) * pool_scale.astype(jnp.float32)
    return y.astype(xb_ext.dtype)


def _even_mixer(h, pool_hist, start, w_in, ln_g, ln_b, w_s, b_s, w_pool, pool_scale, w_out):
    proj = h @ w_in
    u, v, xb = jnp.split(proj, [A_WIDTH, 2 * A_WIDTH], axis=-1)
    u = jax.nn.gelu(u)
    v = _layernorm(jax.nn.gelu(v), ln_g, ln_b)
    ya = _spatial_gate(u, v, w_s, b_s)
    xb_ext = jnp.concatenate([pool_hist.astype(xb.dtype), xb], axis=1)
    yb = _pool_mix(xb_ext, start, w_pool, pool_scale)
    y = jnp.concatenate([ya, yb], axis=-1) @ w_out
    return y, xb_ext[:, -POOL_PAD:], v


def _rope(x, pos):
    half = RET_QK_DIM // 2
    freq = ROPE_BASE ** (-jnp.arange(half, dtype=jnp.float32) / half)
    ang = pos.astype(jnp.float32)[:, None] * freq[None, :]
    cos = jnp.cos(ang)[None, :, None, :]
    sin = jnp.sin(ang)[None, :, None, :]
    x1, x2 = x[..., :half], x[..., half:]
    return jnp.concatenate([x1 * cos - x2 * sin, x1 * sin + x2 * cos], axis=-1)


def _retention_block(s_prev, q, k, v, log_g):
    L = q.shape[1]
    n = jnp.arange(L, dtype=jnp.float32)
    diff = n[:, None] - n[None, :]
    decay = jnp.where(diff >= 0, jnp.exp(jnp.maximum(diff, 0.0)[None] * log_g[:, None, None]), 0.0)
    scores = jnp.einsum('blhd,bmhd->bhlm', q, k) * decay[None]
    intra = jnp.einsum('bhlm,bmhe->blhe', scores, v)
    q_dec = q * jnp.exp((n[:, None] + 1.0) * log_g[None, :])[None, :, :, None]
    cross = jnp.einsum('blhd,bhde->blhe', q_dec, s_prev)
    k_dec = k * jnp.exp((L - 1.0 - n)[:, None] * log_g[None, :])[None, :, :, None]
    s_new = s_prev * jnp.exp(L * log_g)[None, :, None, None] + jnp.einsum('blhd,blhe->bhde', k_dec, v)
    return s_new, intra + cross


def _retention(q, k, v, s0, log_g):
    Bn, S = q.shape[:2]
    blk = min(S, CHUNK)
    nb = S // blk

    def to_blocks(t):
        return jnp.moveaxis(t.reshape(Bn, nb, blk, *t.shape[2:]), 1, 0)

    def step(s, qkv):
        return _retention_block(s, qkv[0], qkv[1], qkv[2], log_g)

    s_fin, o = lax.scan(step, s0, (to_blocks(q), to_blocks(k), to_blocks(v)))
    o = jnp.moveaxis(o, 0, 1).reshape(Bn, S, RET_HEADS, RET_V_DIM)
    return o, s_fin


def _odd_mixer(h, s0, start, w_in, w_out):
    Bn, S, _ = h.shape
    proj = h @ w_in
    q, k, v, g = jnp.split(proj, [D_MODEL, 2 * D_MODEL, 2 * D_MODEL + RET_VW], axis=-1)
    q = q.astype(jnp.float32).reshape(Bn, S, RET_HEADS, RET_QK_DIM)
    k = k.astype(jnp.float32).reshape(Bn, S, RET_HEADS, RET_QK_DIM) * (RET_QK_DIM ** -0.5)
    v = v.astype(jnp.float32).reshape(Bn, S, RET_HEADS, RET_V_DIM)
    pos = start + jnp.arange(S)
    q = _rope(q, pos)
    k = _rope(k, pos)
    log_g = jnp.log1p(-jnp.exp2(-5.0 - jnp.arange(RET_HEADS, dtype=jnp.float32)))
    o, s_fin = _retention(q, k, v, s0.astype(jnp.float32), log_g)
    o = o * lax.rsqrt(jnp.mean(o * o, axis=-1, keepdims=True) + EPS)
    o = o.reshape(Bn, S, RET_VW).astype(h.dtype)
    y = (jax.nn.silu(g) * o) @ w_out
    return y, s_fin.astype(h.dtype)


def _swiglu(h, w_gu, w_down):
    gate, up = jnp.split(h @ w_gu, 2, axis=-1)
    return (jax.nn.silu(gate) * up) @ w_down


def setup_inputs(seed: int = 0) -> dict:
    key = jax.random.key(seed)
    ks = jax.random.split(key, 24)
    nrm = jax.random.normal
    f32 = jnp.float32
    D = D_MODEL
    return {
        'x_prompt': nrm(ks[0], (BATCH, SEQ, D), f32),
        'x_sample': nrm(ks[1], (DEC_BATCH, DEC_SEQ, D), f32),
        'c_prompt': nrm(ks[2], (BATCH, D), f32),
        'c_sample': nrm(ks[3], (DEC_BATCH, D), f32),
        'state_b_pool': nrm(ks[4], (N_EVEN, DEC_BATCH, POOL_PAD, B_WIDTH), f32),
        'state_c_ret': 0.5 * nrm(ks[5], (N_ODD, DEC_BATCH, RET_HEADS, RET_QK_DIM, RET_V_DIM), f32),
        'w_ada': 0.5 * D ** -0.5 * nrm(ks[6], (DEPTH, D, 6 * D), f32),
        'b_ada': 0.01 * nrm(ks[7], (DEPTH, 6 * D), f32),
        'norm_mix': 1.0 + 0.1 * nrm(ks[8], (DEPTH, D), f32),
        'norm_ffn': 1.0 + 0.1 * nrm(ks[9], (DEPTH, D), f32),
        'norm_final': 1.0 + 0.1 * nrm(ks[10], (D,), f32),
        'w_in_ab': D ** -0.5 * nrm(ks[11], (N_EVEN, D, 3 * A_WIDTH), f32),
        'ln_v_g': 1.0 + 0.1 * nrm(ks[12], (N_EVEN, A_WIDTH), f32),
        'ln_v_b': 0.01 * nrm(ks[13], (N_EVEN, A_WIDTH), f32),
        'w_s': 0.5 * A_BLOCK ** -0.5 * nrm(ks[14], (N_EVEN, A_GROUPS, A_BLOCK, A_BLOCK), f32),
        'b_s': 1.0 + 0.1 * nrm(ks[15], (N_EVEN, A_GROUPS, A_BLOCK), f32),
        'w_pool': B_GROUP_DIM ** -0.5 * nrm(ks[16], (N_EVEN, B_GROUPS, B_GROUP_DIM, B_GROUP_DIM), f32),
        'pool_scale': 1.0 + 0.1 * nrm(ks[17], (N_EVEN, B_WIDTH), f32),
        'w_out_ab': (A_WIDTH + B_WIDTH) ** -0.5 * nrm(ks[18], (N_EVEN, A_WIDTH + B_WIDTH, D), f32),
        'w_in_c': D ** -0.5 * nrm(ks[19], (N_ODD, D, 2 * D + 2 * RET_VW), f32),
        'w_out_c': RET_VW ** -0.5 * nrm(ks[20], (N_ODD, RET_VW, D), f32),
        'w_ffn_gu': D ** -0.5 * nrm(ks[21], (DEPTH, D, 2 * D_FF), f32),
        'w_ffn_down': D_FF ** -0.5 * nrm(ks[22], (DEPTH, D_FF, D), f32),
    }


def reference(x_prompt, x_sample, c_prompt, c_sample, state_b_pool, state_c_ret,
              w_ada, b_ada, norm_mix, norm_ffn, norm_final,
              w_in_ab, ln_v_g, ln_v_b, w_s, b_s, w_pool, pool_scale, w_out_ab,
              w_in_c, w_out_c, w_ffn_gu, w_ffn_down):
    bp = x_prompt.shape[0]
    zero_pool = jnp.zeros((bp, POOL_PAD, B_WIDTH), x_prompt.dtype)
    zero_ret = jnp.zeros((bp, RET_HEADS, RET_QK_DIM, RET_V_DIM), jnp.float32)
    xp, xs = x_prompt, x_sample
    pool_p, pool_s, v_s, ret_p, ret_s = [], [], [], [], []
    for layer in range(DEPTH):
        mp = _ada(c_prompt, w_ada[layer], b_ada[layer])
        ms = _ada(c_sample, w_ada[layer], b_ada[layer])
        hp = _modulate(_rmsnorm(xp, norm_mix[layer]), mp[0], mp[1])
        hs = _modulate(_rmsnorm(xs, norm_mix[layer]), ms[0], ms[1])
        if layer % 2 == 0:
            e = layer // 2
            prm = (w_in_ab[e], ln_v_g[e], ln_v_b[e], w_s[e], b_s[e], w_pool[e], pool_scale[e], w_out_ab[e])
            op, new_pp, _ = _even_mixer(hp, zero_pool, 0, *prm)
            osm, new_ps, new_vs = _even_mixer(hs, state_b_pool[e], PAST_LEN, *prm)
            pool_p.append(new_pp)
            pool_s.append(new_ps)
            v_s.append(new_vs)
        else:
            o = layer // 2
            op, new_rp = _odd_mixer(hp, zero_ret, 0, w_in_c[o], w_out_c[o])
            osm, new_rs = _odd_mixer(hs, state_c_ret[o], PAST_LEN, w_in_c[o], w_out_c[o])
            ret_p.append(new_rp)
            ret_s.append(new_rs)
        xp = xp + mp[2] * op
        xs = xs + ms[2] * osm
        hp = _modulate(_rmsnorm(xp, norm_ffn[layer]), mp[3], mp[4])
        hs = _modulate(_rmsnorm(xs, norm_ffn[layer]), ms[3], ms[4])
        xp = xp + mp[5] * _swiglu(hp, w_ffn_gu[layer], w_ffn_down[layer])
        xs = xs + ms[5] * _swiglu(hs, w_ffn_gu[layer], w_ffn_down[layer])
    y_prompt = _rmsnorm(xp, norm_final)
    y_sample = _rmsnorm(xs, norm_final)
    return (y_prompt, y_sample, jnp.stack(pool_p), jnp.stack(pool_s), jnp.stack(v_s), jnp.stack(ret_p), jnp.stack(ret_s))
```

```cpp
#include <hip/hip_runtime.h>
#include <hip/hip_cooperative_groups.h>
#include <cstdio>
#include <cstdint>
namespace cg = cooperative_groups;
namespace pg8 {
#define PG8_LAS __attribute__((address_space(3)))
typedef unsigned short bf16_t;
typedef short bf16x8 __attribute__((ext_vector_type(8)));
typedef float f32x4 __attribute__((ext_vector_type(4)));
typedef unsigned u32x4 __attribute__((ext_vector_type(4)));
constexpr int BM = 256, BK = 64, HALF = 128, HTB = HALF * BK * 2  , STAGE_BYTES = 8 * HTB, NXCD = 8, WGM = 8;

__host__ __device__ __forceinline__ int lds_byte(int r, int c) { const int st = (r >> 4) * 2 + (c >> 5), rr = r & 15, cc = c & 31, ob = rr * 64 + cc * 2; return st * 1024 + (ob ^ (((ob >> 9) & 1) << 5)); }
__host__ __device__ __forceinline__ void stage_rc(int b, int& R, int& C) { const int st = b / 1024, sb = b % 1024, swz = sb ^ (((sb >> 9) & 1) << 5); R = (st >> 1) * 16 + swz / 64; C = (st & 1) * 32 + (swz % 64) / 2; }
__host__ __device__ __forceinline__ int perm32(int rho) { const int n = rho >> 4, i = rho & 15; return 8 * (i >> 2) + 4 * n + (i & 3); }

struct Unit { int pm, pn, k0; };
struct Gemm { const bf16_t* A; const bf16_t* Bt; int M, N, K, KL; };

struct StaticOrder {
    int nM, nN, nwg, G, c;
    __host__ __device__ void init(int M, int N, int G_, int c_) { nM = M / BM; nN = N / BM; nwg = nM * nN; G = G_; c = c_; }
    __host__ __device__ bool next(int i, Unit& u) const {
        const long L = (long)i * G + c; if (L >= nwg) return false;
        int wgid = (int)L; { const int q = nwg / NXCD, r = nwg % NXCD, xcd = wgid % NXCD, off = wgid / NXCD; wgid = (xcd < r ? xcd * (q + 1) : r * (q + 1) + (xcd - r) * q) + off; }
        const int nig = WGM * nN, gid = wgid / nig, fm = gid * WGM, gsz = (nM - fm) < WGM ? (nM - fm) : WGM;
        u.pm = fm + ((wgid % nig) % gsz); u.pn = (wgid % nig) / gsz; u.k0 = 0; return true;
    }
    __device__ __forceinline__ void a_ready(const Unit&) const {}
    __device__ __forceinline__ void done(const Unit&) const {}
};

__device__ __forceinline__ unsigned cvt_pk_bf16(float lo, float hi) { unsigned r; asm volatile("v_cvt_pk_bf16_f32 %0, %1, %2" : "=v"(r) : "v"(lo), "v"(hi)); return r; }
typedef float f32x2 __attribute__((ext_vector_type(2)));
template <class Epi, class Sched, bool ALIGN_EPI = false, bool SP2 = false>
__device__ __forceinline__ void gemm_phase(PG8_LAS unsigned char* lds, const Gemm g, const Sched& S, const Epi& E) {
    const int tid = threadIdx.x, wid = __builtin_amdgcn_readfirstlane(tid >> 6), lane = tid & 63, wr = wid >> 2, wc = wid & 3, fr = lane & 15, fq = lane >> 4;
    const int K = g.K, nt = g.KL / BK;
    unsigned voffA[2], voffB[2];
#pragma unroll
    for (int i = 0; i < 2; ++i) { int R, C; stage_rc(tid * 16 + i * 8192, R, C); const int Rb = Epi::PERM ? ((R & ~31) + perm32(R & 31)) : R;
        voffA[i] = (unsigned)(R * K + C) * 2u; voffB[i] = (unsigned)(Rb * K + C) * 2u; }
    const size_t kstep = (size_t)(BK * 2);
    const size_t hstep = (size_t)HALF * K * 2;
    const size_t tstep = 2 * hstep;
    const unsigned ldsw = (unsigned)wid * 1024u;
    const int aoff = lds_byte(wr * 64 + fr, fq * 8), boff = lds_byte(wc * 32 + fr, fq * 8);
#define PG8_SA(b, h) (((b) * 2 + (h)) * HTB)
#define PG8_SB(b, h) ((4 + (b) * 2 + (h)) * HTB)
#define PG8_STAGE(bufoff, gbase, voff) do { _Pragma("unroll") for (int _i = 0; _i < 2; ++_i) \
        __builtin_amdgcn_global_load_lds((const unsigned*)((const char*)(gbase) + (voff)[_i]), (PG8_LAS unsigned*)(lds + (bufoff) + ldsw + _i * 8192), 16, 0, 0); } while (0)
#define PG8_LDA(dst, b, h) do { _Pragma("unroll") for (int m = 0; m < 4; ++m) _Pragma("unroll") for (int k = 0; k < 2; ++k) dst[m][k] = *(const PG8_LAS bf16x8*)(lds + PG8_SA(b, h) + aoff + m * 2048 + k * 1024); } while (0)
#define PG8_LDB(dst, b, h) do { _Pragma("unroll") for (int n = 0; n < 2; ++n) _Pragma("unroll") for (int k = 0; k < 2; ++k) dst[n][k] = *(const PG8_LAS bf16x8*)(lds + PG8_SB(b, h) + boff + n * 2048 + k * 1024); } while (0)
#define PG8_MMA(ai, bj, At, Bt) do { __builtin_amdgcn_s_setprio(1); _Pragma("unroll") for (int m = 0; m < 4; ++m) _Pragma("unroll") for (int n = 0; n < 2; ++n) _Pragma("unroll") for (int k = 0; k < 2; ++k) \
        acc[ai][bj][m][n] = __builtin_amdgcn_mfma_f32_16x16x32_bf16(Bt[n][k], At[m][k], acc[ai][bj][m][n], 0, 0, 0); __builtin_amdgcn_s_setprio(0); } while (0)
#define PG8_WAIT_V(n) asm volatile("s_waitcnt vmcnt(" #n ")" ::: "memory")
#define PG8_WAIT_L(n) asm volatile("s_waitcnt lgkmcnt(" #n ")" ::: "memory")
#define PG8_BAR __builtin_amdgcn_s_barrier()
#define PG8_SCHED __builtin_amdgcn_sched_barrier(0)
    Unit cur, nxt; int ui = 0;
    if (!S.next(0, cur)) return;
    f32x4 acc[2][2][4][2];
#pragma unroll
    for (int a = 0; a < 2; ++a)
#pragma unroll
        for (int b = 0; b < 2; ++b)
#pragma unroll
            for (int m = 0; m < 4; ++m)
#pragma unroll
                for (int n = 0; n < 2; ++n) acc[a][b][m][n] = (f32x4){0.f, 0.f, 0.f, 0.f};
    bf16x8 At[4][2], B0[2][2], B1[2][2];
    const char* cA = (const char*)g.A + (size_t)cur.pm * tstep + (size_t)cur.k0 * 2; const char* cB = (const char*)g.Bt + (size_t)cur.pn * tstep + (size_t)cur.k0 * 2;
    S.a_ready(cur);
    if constexpr (SP2) {
        PG8_STAGE(PG8_SB(0, 0), cB, voffB); PG8_STAGE(PG8_SB(0, 1), cB + hstep, voffB); PG8_STAGE(PG8_SA(0, 0), cA, voffA); PG8_STAGE(PG8_SA(0, 1), cA + hstep, voffA);
        if (wr == 1) PG8_BAR;
        PG8_WAIT_V(2); PG8_BAR;
        PG8_STAGE(PG8_SB(1, 0), cB + kstep, voffB); PG8_STAGE(PG8_SA(1, 0), cA + kstep, voffA); PG8_STAGE(PG8_SB(1, 1), cB + hstep + kstep, voffB);
        PG8_WAIT_V(6); PG8_BAR;
    } else {
        PG8_STAGE(PG8_SB(0, 0), cB, voffB); PG8_STAGE(PG8_SA(0, 0), cA, voffA); PG8_STAGE(PG8_SB(0, 1), cB + hstep, voffB); PG8_STAGE(PG8_SA(0, 1), cA + hstep, voffA);
        if (wr == 1) PG8_BAR;
        PG8_WAIT_V(4); PG8_BAR;
        PG8_STAGE(PG8_SB(1, 0), cB + kstep, voffB); PG8_STAGE(PG8_SA(1, 0), cA + kstep, voffA); PG8_STAGE(PG8_SB(1, 1), cB + hstep + kstep, voffB);
        PG8_WAIT_V(6); PG8_BAR;
    }
    for (;;) {
        const bool has_next = S.next(ui + 1, nxt);
        const char* nA = has_next ? (const char*)g.A + (size_t)nxt.pm * tstep + (size_t)nxt.k0 * 2 : cA; const char* nB = has_next ? (const char*)g.Bt + (size_t)nxt.pn * tstep + (size_t)nxt.k0 * 2 : cB;
        for (int t = 0; t < nt; t += 2) {
            const bool last = (t == nt - 2);
            const char* a1 = cA + (size_t)(t + 1) * kstep;
            const char* a2 = last ? nA : cA + (size_t)(t + 2) * kstep; const char* b2 = last ? nB : cB + (size_t)(t + 2) * kstep;
            const char* a3 = a2 + kstep; const char* b3 = b2 + kstep;
            if (last && has_next) S.a_ready(nxt);
            if constexpr (SP2) {
            PG8_LDB(B0, 0, 0); PG8_LDB(B1, 0, 1); PG8_SCHED; PG8_LDA(At, 0, 0); PG8_STAGE(PG8_SA(1, 1), a1 + hstep, voffA);
            PG8_WAIT_V(8); PG8_WAIT_L(0); PG8_BAR; PG8_MMA(0, 0, At, B0); PG8_MMA(0, 1, At, B1); PG8_BAR; PG8_SCHED;
            PG8_LDA(At, 0, 1); PG8_STAGE(PG8_SB(0, 0), b2, voffB); PG8_STAGE(PG8_SB(0, 1), b2 + hstep, voffB); PG8_STAGE(PG8_SA(0, 0), a2, voffA);
            PG8_WAIT_V(8); PG8_WAIT_L(0); PG8_BAR; PG8_MMA(1, 0, At, B0); PG8_MMA(1, 1, At, B1); PG8_BAR; PG8_SCHED;
            PG8_LDB(B0, 1, 0); PG8_LDB(B1, 1, 1); PG8_SCHED; PG8_LDA(At, 1, 0); PG8_STAGE(PG8_SA(0, 1), a2 + hstep, voffA);
            PG8_WAIT_V(8); PG8_WAIT_L(0); PG8_BAR; PG8_MMA(0, 0, At, B0); PG8_MMA(0, 1, At, B1); PG8_BAR; PG8_SCHED;
            PG8_LDA(At, 1, 1); PG8_STAGE(PG8_SB(1, 0), b3, voffB); PG8_STAGE(PG8_SB(1, 1), b3 + hstep, voffB); PG8_STAGE(PG8_SA(1, 0), a3, voffA);
            PG8_WAIT_V(8); PG8_WAIT_L(0); PG8_BAR; PG8_MMA(1, 0, At, B0); PG8_MMA(1, 1, At, B1); PG8_BAR; PG8_SCHED;
            } else {
            PG8_LDB(B0, 0, 0); PG8_SCHED; PG8_LDA(At, 0, 0); PG8_STAGE(PG8_SA(1, 1), a1 + hstep, voffA);
            PG8_WAIT_L(8); PG8_BAR; PG8_WAIT_L(0); PG8_MMA(0, 0, At, B0); PG8_BAR; PG8_SCHED;
            PG8_LDB(B1, 0, 1); PG8_STAGE(PG8_SB(0, 0), b2, voffB);
            PG8_BAR; PG8_WAIT_L(0); PG8_MMA(0, 1, At, B1); PG8_BAR;
            PG8_LDA(At, 0, 1); PG8_STAGE(PG8_SA(0, 0), a2, voffA);
            PG8_BAR; PG8_WAIT_L(0); PG8_MMA(1, 0, At, B0); PG8_BAR; PG8_SCHED;
            PG8_STAGE(PG8_SB(0, 1), b2 + hstep, voffB);
            PG8_WAIT_V(6); PG8_BAR; PG8_MMA(1, 1, At, B1); PG8_BAR;
            PG8_LDB(B0, 1, 0); PG8_SCHED; PG8_LDA(At, 1, 0); PG8_STAGE(PG8_SA(0, 1), a2 + hstep, voffA);
            PG8_WAIT_L(8); PG8_BAR; PG8_WAIT_L(0); PG8_MMA(0, 0, At, B0); PG8_BAR; PG8_SCHED;
            PG8_LDB(B1, 1, 1); PG8_STAGE(PG8_SB(1, 0), b3, voffB);
            PG8_BAR; PG8_WAIT_L(0); PG8_MMA(0, 1, At, B1); PG8_BAR;
            PG8_LDA(At, 1, 1); PG8_STAGE(PG8_SA(1, 0), a3, voffA);
            PG8_BAR; PG8_WAIT_L(0); PG8_MMA(1, 0, At, B0); PG8_BAR; PG8_SCHED;
            PG8_STAGE(PG8_SB(1, 1), b3 + hstep, voffB);
            PG8_WAIT_V(6); PG8_BAR; PG8_MMA(1, 1, At, B1); PG8_BAR;
            }
        }
        if constexpr (ALIGN_EPI) { if (wr == 0) PG8_BAR; }
        if constexpr (!Epi::AFTER_DRAIN) { E(acc, cur, wr, wc, fr, fq); S.done(cur); }
        if (!has_next) break;
#pragma unroll
        for (int a = 0; a < 2; ++a)
#pragma unroll
            for (int b = 0; b < 2; ++b)
#pragma unroll
                for (int m = 0; m < 4; ++m)
#pragma unroll
                    for (int n = 0; n < 2; ++n) acc[a][b][m][n] = (f32x4){0.f, 0.f, 0.f, 0.f};
        cur = nxt; cA = nA; cB = nB; ++ui;
        if constexpr (ALIGN_EPI) { if (wr == 1) PG8_BAR; }
    }
    PG8_WAIT_V(0);
    if constexpr (!ALIGN_EPI) { if (wr == 0) PG8_BAR; }
    PG8_BAR;
    if constexpr (Epi::AFTER_DRAIN) { E.fused(acc, cur, wr, wc, fr, fq, lds, wid, lane); S.done(cur); }
#undef PG8_SA
#undef PG8_SB
#undef PG8_STAGE
#undef PG8_LDA
#undef PG8_LDB
#undef PG8_MMA
#undef PG8_WAIT_V
#undef PG8_WAIT_L
#undef PG8_BAR
#undef PG8_SCHED
}
}
#define LAS __attribute__((address_space(3)))
typedef unsigned short bf16;
typedef float f32x4 __attribute__((ext_vector_type(4)));
typedef float f32x2 __attribute__((ext_vector_type(2)));
typedef unsigned u32x4 __attribute__((ext_vector_type(4)));
typedef unsigned u32x2 __attribute__((ext_vector_type(2)));
typedef short bf16x8 __attribute__((ext_vector_type(8)));
typedef short s16x4 __attribute__((ext_vector_type(4)));

constexpr int D = 2048, SEQ = 8192, MP = 16384, MS = 512, M = MP + MS, NBI = 18;
constexpr int AW = 1024, DFF = 5632, NQKVG = 12288, VW = 4096, NMOD = 12288;
constexpr float EPS = 1e-6f;
constexpr int LDS_BYTES = 147456;

constexpr size_t OUT_Y = 0, OUT_POOLP = 34603008, OUT_POOLS = 34633728, OUT_VS = 34879488, OUT_RETP = 35403776, OUT_RETS = 37500928;
constexpr size_t WS_BAR = 0;
constexpr size_t WS_MODS = 65536;
constexpr size_t WS_COS = 3u << 20, WS_SIN = WS_COS + 4194304;
constexpr size_t WS_WSA = WS_SIN + 4194304;
constexpr size_t WS_WSB = WS_WSA + 262144;
constexpr size_t WS_WPT = WS_WSB + 262144;
constexpr size_t WS_PP = WS_WPT + 524288;
constexpr size_t WS_PS = WS_PP + 16777216;
constexpr size_t WS_W = 32u << 20;
constexpr size_t W0_IN = 0, W0_OUT = W0_IN + (size_t)3072 * 2048 * 2, W0_GU = W0_OUT + (size_t)2048 * 2048 * 2, W0_DN = W0_GU + (size_t)11264 * 2048 * 2;
constexpr size_t W1_IN = 0, W1_OUT = W1_IN + (size_t)12288 * 2048 * 2, W1_GU = W1_OUT + (size_t)2048 * 4096 * 2, W1_DN = W1_GU + (size_t)11264 * 2048 * 2;
constexpr size_t W_BYTES = W1_DN + (size_t)2048 * 5632 * 2;
constexpr size_t WS_H = WS_W + W_BYTES;
constexpr size_t WS_R = WS_H + (size_t)M * 2048 * 2;
constexpr size_t R_U = 0, R_V = R_U + (size_t)M * 1024 * 2, R_XB = R_V + (size_t)M * 1024 * 2;
constexpr size_t R_ACT = 0;
constexpr size_t R_Q = 0, R_K = R_Q + (size_t)M * 2048 * 2, R_VV = R_K + (size_t)M * 2048 * 2, R_G = R_VV + (size_t)M * 4096 * 2, R_O = R_G + (size_t)M * 4096 * 2;
constexpr size_t WS_END = WS_R + R_O + (size_t)M * 4096 * 2;
static_assert(WS_PS + 262144 <= WS_W, "ws map");
static_assert(WS_END <= 850000000ull, "ws too large");

__device__ __forceinline__ float bf2f(unsigned h) { return __uint_as_float(h << 16); }
typedef __bf16 bf16x2_t __attribute__((ext_vector_type(2)));
__device__ __forceinline__ unsigned pk2(float lo, float hi) { const f32x2 v = {lo, hi}; return __builtin_bit_cast(unsigned, __builtin_convertvector(v, bf16x2_t)); }
__device__ __forceinline__ float silu_f(float x) { return x * __builtin_amdgcn_rcpf(1.0f + __expf(-x)); }
__device__ __forceinline__ float gelu_tanh_f(float x) { const float z = 0.7978845608028654f * (x + 0.044715f * x * x * x); return x * __builtin_amdgcn_rcpf(1.0f + __expf(-2.0f * z)); }
__device__ __forceinline__ float wave_sum(float v) {
#pragma unroll
    for (int o = 1; o < 64; o <<= 1) v += __shfl_xor(v, o);
    return v;
}
__device__ __forceinline__ void unpack8(const u32x4 w, float (&f)[8]) {
    f[0] = __uint_as_float(w.x << 16); f[1] = __uint_as_float(w.x & 0xffff0000u); f[2] = __uint_as_float(w.y << 16); f[3] = __uint_as_float(w.y & 0xffff0000u);
    f[4] = __uint_as_float(w.z << 16); f[5] = __uint_as_float(w.z & 0xffff0000u); f[6] = __uint_as_float(w.w << 16); f[7] = __uint_as_float(w.w & 0xffff0000u);
}
__device__ __forceinline__ u32x4 pack8(const float (&f)[8]) { u32x4 w; w.x = pk2(f[0], f[1]); w.y = pk2(f[2], f[3]); w.z = pk2(f[4], f[5]); w.w = pk2(f[6], f[7]); return w; }
__device__ __forceinline__ int row_bi(int row) { return row < MP ? (row >> 13) : 2 + ((row - MP) >> 5); }
__device__ __forceinline__ float head_log_g(int h) { return log1pf(-exp2f(-5.0f - (float)h)); }
#define MFMA16(a, b, c) __builtin_amdgcn_mfma_f32_16x16x32_bf16((a), (b), (c), 0, 0, 0)
__device__ __forceinline__ int hm_row(int r, int h) { return r < MP ? (((r >> 13) * 8 + h) << 13) + (r & 8191) : MP * 8 + ((((r - MP) >> 5) * 8 + h) << 5) + ((r - MP) & 31); }
struct EpiInAB {
    static constexpr bool PERM = true, AFTER_DRAIN = false;
    bf16* U; bf16* V; bf16* XB; float* poolP; float* poolS;
    __device__ __forceinline__ void operator()(const f32x4 (&acc)[2][2][4][2], const pg8::Unit& u, int wr, int wc, int fr, int fq) const {
        const int t = u.pn >> 2, colt = (u.pn & 3) * 256 + wc * 32 + 8 * fq;
        bf16* base = U + (size_t)t * ((size_t)M * 1024);
#pragma unroll
        for (int ai = 0; ai < 2; ++ai)
#pragma unroll
            for (int m = 0; m < 4; ++m) {
                const int row = u.pm * 256 + ai * 128 + wr * 64 + m * 16 + fr;
                bf16* rowp = base + (size_t)row * 1024 + colt;
                float* sp = nullptr;
                if (t == 2) {
                    if (row < MP) { const int pos = row & 8191; if (pos >= 8177) sp = poolP + ((size_t)(row >> 13) * 15 + (pos - 8177)) * 1024 + colt; }
                    else { const int i = (row - MP) & 31; if (i >= 17) sp = poolS + ((size_t)((row - MP) >> 5) * 15 + (i - 17)) * 1024 + colt; }
                }
#pragma unroll
                for (int bj = 0; bj < 2; ++bj) {
                    f32x4 v0 = acc[ai][bj][m][0], v1 = acc[ai][bj][m][1];
                    if (t < 2) {
#pragma unroll
                        for (int j = 0; j < 4; ++j) { v0[j] = gelu_tanh_f(v0[j]); v1[j] = gelu_tanh_f(v1[j]); }
                    }
                    u32x4 w; w.x = pk2(v0[0], v0[1]); w.y = pk2(v0[2], v0[3]); w.z = pk2(v1[0], v1[1]); w.w = pk2(v1[2], v1[3]);
                    *(u32x4*)(rowp + bj * 128) = w;
                    if (sp) { *(f32x4*)(sp + bj * 128) = v0; *(f32x4*)(sp + bj * 128 + 4) = v1; }
                }
            }
    }
};
struct EpiRes {
    static constexpr bool PERM = false, AFTER_DRAIN = false;
    const float* baseP; const float* baseS; float* out; const float* gate;
    __device__ __forceinline__ void operator()(const f32x4 (&acc)[2][2][4][2], const pg8::Unit& u, int wr, int wc, int fr, int fq) const {
        const int col0 = u.pn * 256 + wc * 32 + 4 * fq;
#pragma unroll
        for (int ai = 0; ai < 2; ++ai)
#pragma unroll
            for (int m = 0; m < 4; ++m) {
                const int row = u.pm * 256 + ai * 128 + wr * 64 + m * 16 + fr;
                const float* bp = row < MP ? baseP + (size_t)row * D : baseS + (size_t)(row - MP) * D;
                const float* gp = gate + (size_t)row_bi(row) * NMOD;
                float* op = out + (size_t)row * D;
#pragma unroll
                for (int bj = 0; bj < 2; ++bj)
#pragma unroll
                    for (int n = 0; n < 2; ++n) { const int c = col0 + bj * 128 + n * 16;
                        const f32x4 b = *(const f32x4*)(bp + c), g = *(const f32x4*)(gp + c);
                        *(f32x4*)(op + c) = b + g * acc[ai][bj][m][n]; }
                if (m & 1) asm volatile("" ::: "memory");
            }
    }
};
struct EpiSwiGLU {
    static constexpr bool PERM = true, AFTER_DRAIN = false;
    bf16* ACT;
    __device__ __forceinline__ void operator()(const f32x4 (&acc)[2][2][4][2], const pg8::Unit& u, int wr, int wc, int fr, int fq) const {
        const int col0 = u.pn * 128 + wc * 32 + 8 * fq;
#pragma unroll
        for (int ai = 0; ai < 2; ++ai)
#pragma unroll
            for (int m = 0; m < 4; ++m) {
                const int row = u.pm * 256 + ai * 128 + wr * 64 + m * 16 + fr;
                float o[8];
#pragma unroll
                for (int n = 0; n < 2; ++n)
#pragma unroll
                    for (int j = 0; j < 4; ++j) o[n * 4 + j] = silu_f(acc[ai][0][m][n][j]) * acc[ai][1][m][n][j];
                *(u32x4*)(ACT + (size_t)row * DFF + col0) = pack8(o);
            }
    }
};
struct EpiQKVG {
    static constexpr bool PERM = true, AFTER_DRAIN = false;
    bf16* Q; bf16* K; bf16* V; bf16* G; const float* COS; const float* SIN;
    __device__ __forceinline__ void operator()(const f32x4 (&acc)[2][2][4][2], const pg8::Unit& u, int wr, int wc, int fr, int fq) const {
        const int pn = u.pn;
        if (pn < 16) {
            const int h = pn & 7; const bool isk = pn >= 8; const float lg = head_log_g(h) * 1.4426950408889634f;
            bf16* base = Q + (isk ? (size_t)M * 2048 : (size_t)0) + wc * 32 + 8 * fq;
            const int ch = wc * 32 + 8 * fq;
#pragma unroll
            for (int ai = 0; ai < 2; ++ai)
#pragma unroll
                for (int m = 0; m < 4; ++m) {
                    const int row = u.pm * 256 + ai * 128 + wr * 64 + m * 16 + fr;
                    int pos, n, L;
                    if (row < MP) { pos = row & 8191; n = pos & 63; L = 64; } else { n = (row - MP) & 31; pos = 2048 + n; L = 32; }
                    const float sc = isk ? 0.0625f * exp2f(lg * (float)(L - 1 - n)) : exp2f(lg * (float)(n + 1));
                    const f32x4 c0 = *(const f32x4*)(COS + (size_t)pos * 128 + ch), c1 = *(const f32x4*)(COS + (size_t)pos * 128 + ch + 4);
                    const f32x4 s0 = *(const f32x4*)(SIN + (size_t)pos * 128 + ch), s1 = *(const f32x4*)(SIN + (size_t)pos * 128 + ch + 4);
                    float o1[8], o2[8];
#pragma unroll
                    for (int j = 0; j < 4; ++j) {
                        const float a0 = acc[ai][0][m][0][j], b0 = acc[ai][1][m][0][j], a1 = acc[ai][0][m][1][j], b1 = acc[ai][1][m][1][j];
                        o1[j] = (a0 * c0[j] - b0 * s0[j]) * sc; o2[j] = (a0 * s0[j] + b0 * c0[j]) * sc;
                        o1[4 + j] = (a1 * c1[j] - b1 * s1[j]) * sc; o2[4 + j] = (a1 * s1[j] + b1 * c1[j]) * sc;
                    }
                    const int hrow = hm_row(row, h);
                    if (isk) { const size_t hr = (size_t)hrow * 256; *(u32x4*)(base + hr) = pack8(o1); *(u32x4*)(base + hr + 128) = pack8(o2); }
                    else {
                        bf16* qt = Q + ((size_t)(hrow >> 4) * 8 + wc) * 512 + (fq * 16 + (hrow & 15)) * 8;
                        *(u32x4*)qt = pack8(o1); *(u32x4*)(qt + 4 * 512) = pack8(o2); }
                }
        } else {
            const bool isg = pn >= 32; const int hv = (pn - 16) >> 1;
            bf16* base = V + (isg ? (size_t)M * 4096 + (size_t)(pn - 32) * 256 : (size_t)((pn - 16) & 1) * 256) + wc * 32 + 8 * fq;
#pragma unroll
            for (int ai = 0; ai < 2; ++ai)
#pragma unroll
                for (int m = 0; m < 4; ++m) {
                    const int row = u.pm * 256 + ai * 128 + wr * 64 + m * 16 + fr;
#pragma unroll
                    for (int bj = 0; bj < 2; ++bj) {
                        float o[8];
#pragma unroll
                        for (int n = 0; n < 2; ++n)
#pragma unroll
                            for (int j = 0; j < 4; ++j) { const float x = acc[ai][bj][m][n][j]; o[n * 4 + j] = isg ? silu_f(x) : x; }
                        *(u32x4*)(base + (isg ? (size_t)row * VW : (size_t)hm_row(row, hv) * 512) + bj * 128) = pack8(o);
                    }
                }
        }
    }
};
struct SplitOrder {
    int nN, KS, KL, G, c;
    __device__ __forceinline__ bool next(int i, pg8::Unit& u) const { const int L = i * G + c; if (L >= 2 * nN * KS) return false; u.pm = 64 + (L & 1); const int r = L >> 1; u.pn = r % nN; u.k0 = (r / nN) * KL; return true; }
    __device__ __forceinline__ void a_ready(const pg8::Unit&) const {}
    __device__ __forceinline__ void done(const pg8::Unit&) const {}
};
struct EpiPartial {
    static constexpr bool PERM = false, AFTER_DRAIN = false;
    float* PART; int KL;
    __device__ __forceinline__ void operator()(const f32x4 (&acc)[2][2][4][2], const pg8::Unit& u, int wr, int wc, int fr, int fq) const {
        const int col0 = u.pn * 256 + wc * 32 + 4 * fq, ks = u.k0 / KL;
#pragma unroll
        for (int ai = 0; ai < 2; ++ai)
#pragma unroll
            for (int m = 0; m < 4; ++m) {
                const int r = (u.pm - 64) * 256 + ai * 128 + wr * 64 + m * 16 + fr;
                float* op = PART + ((size_t)ks * MS + r) * D;
#pragma unroll
                for (int bj = 0; bj < 2; ++bj)
#pragma unroll
                    for (int n = 0; n < 2; ++n) *(f32x4*)(op + col0 + bj * 128 + n * 16) = acc[ai][bj][m][n];
            }
    }
};
__device__ __forceinline__ void transpose_item(const float* W, int K, int N, bf16* WT, int k0, int n0, int drow0, LAS float* scr, int lane) {
    float wv[32];
#pragma unroll
    for (int i = 0; i < 32; ++i) { const int kk = 2 * i + (lane >> 5); wv[i] = W[(size_t)(k0 + kk) * N + n0 + (lane & 31)]; }
#pragma unroll
    for (int i = 0; i < 32; ++i) { const int kk = 2 * i + (lane >> 5); scr[kk * 33 + (lane & 31)] = wv[i]; }
    asm volatile("s_waitcnt lgkmcnt(0)" ::: "memory");
    const int c = lane & 7;
#pragma unroll
    for (int j = 0; j < 4; ++j) { const int n = (lane >> 3) + 8 * j; const LAS float* s = scr + (8 * c) * 33 + n;
        u32x4 o; o.x = pk2(s[0 * 33], s[1 * 33]); o.y = pk2(s[2 * 33], s[3 * 33]); o.z = pk2(s[4 * 33], s[5 * 33]); o.w = pk2(s[6 * 33], s[7 * 33]);
        *(u32x4*)(WT + (size_t)(drow0 + n) * K + k0 + 8 * c) = o; }
    asm volatile("s_waitcnt lgkmcnt(0)" ::: "memory");
}
__device__ __forceinline__ void convert_weight(const float* W, int K, int N, bf16* WT, int mode, LAS float* scr, int lane, int gw, int ngw) {
    const int nblk = N / 32, nitems = (K / 64) * nblk;
    for (int it = gw; it < nitems; it += ngw) {
        const int kb = it / nblk, nb = it % nblk, n0 = nb * 32;
        int drow0 = n0;
        if (mode == 1) { if (n0 < DFF) drow0 = (n0 >> 7) * 256 + (n0 & 127); else { const int j0 = n0 - DFF; drow0 = (j0 >> 7) * 256 + 128 + (j0 & 127); } }
        transpose_item(W, K, N, WT, kb * 64, n0, drow0, scr, lane);
    }
}

__device__ __forceinline__ void ph_prologue(const float* const* in, unsigned char* ws, LAS unsigned char* lds) {
    const int tid = threadIdx.x, lane = tid & 63, wave = tid >> 6, G = gridDim.x;
    const float* c_p = in[2]; const float* c_s = in[3]; const float* w_ada = in[6]; const float* b_ada = in[7];
    float* mods = (float*)(ws + WS_MODS);
    LAS float* sc = (LAS float*)lds;
    LAS float* red = (LAS float*)(lds + 73728);
    for (int it = blockIdx.x; it < 192; it += G) {
        const int l = it / 96, nb = it % 96;
        const float* W = w_ada + (size_t)l * D * NMOD;
        f32x4 acc[NBI];
#pragma unroll
        for (int b = 0; b < NBI; ++b) acc[b] = (f32x4){0.f, 0.f, 0.f, 0.f};
        const int hh = lane >> 5, c4 = lane & 31;
        for (int kh = 0; kh < 2; ++kh) {
            __syncthreads();
            for (int e = tid; e < NBI * 1024; e += 512) { const int bi = e >> 10, kk = e & 1023;
                const float cv = bi < 2 ? c_p[bi * D + kh * 1024 + kk] : c_s[(bi - 2) * D + kh * 1024 + kk]; sc[e] = cv / (1.0f + __expf(-cv)); }
            __syncthreads();
            const float* wp = W + (size_t)(kh * 1024 + wave * 128 + hh) * NMOD + nb * 128 + c4 * 4;
            for (int j0 = 0; j0 < 64; j0 += 16) {
                f32x4 wv[16];
#pragma unroll
                for (int j = 0; j < 16; ++j) wv[j] = __builtin_nontemporal_load((const f32x4*)(wp + (size_t)(2 * (j0 + j)) * NMOD));
#pragma unroll
                for (int j = 0; j < 16; ++j) { const int kk = wave * 128 + 2 * (j0 + j) + hh;
#pragma unroll
                    for (int b = 0; b < NBI; ++b) { const float s = sc[b * 1024 + kk]; acc[b] += s * wv[j]; } }
            }
        }
#pragma unroll
        for (int b = 0; b < NBI; ++b)
#pragma unroll
            for (int q = 0; q < 4; ++q) acc[b][q] += __shfl_xor(acc[b][q], 32);
        if (lane < 32) {
#pragma unroll
            for (int b = 0; b < NBI; ++b) *(LAS f32x4*)(red + (wave * NBI + b) * 128 + c4 * 4) = acc[b];
        }
        __syncthreads();
        for (int e = tid; e < NBI * 128; e += 512) { const int bi = e >> 7, cc = e & 127;
            float s = b_ada[l * NMOD + nb * 128 + cc];
#pragma unroll
            for (int w = 0; w < 8; ++w) s += red[(w * NBI + bi) * 128 + cc];
            mods[(size_t)(l * NBI + bi) * NMOD + nb * 128 + cc] = s; }
    }
    __syncthreads();
    {
        LAS float* scr = (LAS float*)(lds + wave * 16384);
        const int gw = blockIdx.x * 8 + wave, ngw = G * 8;
        unsigned char* wb = ws + WS_W;
        convert_weight(in[11], D, 3072, (bf16*)(wb + W0_IN), 0, scr, lane, gw, ngw);
        convert_weight(in[18], D, D, (bf16*)(wb + W0_OUT), 0, scr, lane, gw, ngw);
        convert_weight(in[21], D, 2 * DFF, (bf16*)(wb + W0_GU), 1, scr, lane, gw, ngw);
        convert_weight(in[22], DFF, D, (bf16*)(wb + W0_DN), 0, scr, lane, gw, ngw);
    }
    const int gt = blockIdx.x * 512 + tid, ngt = G * 512;
    { const float* w_s = in[14]; bf16* wsa = (bf16*)(ws + WS_WSA); bf16* wsb = (bf16*)(ws + WS_WSB);
      for (int e = gt; e < 8 * 128 * 128; e += ngt) { const int g = e >> 14, t = (e >> 7) & 127, s = e & 127;
          const float a = ((s >> 6) <= (t >> 6)) ? w_s[e] : 0.f;
          const float b = ((s >> 5) == (t >> 5)) ? w_s[(g * 128 + (t & 31)) * 128 + (s & 31)] : 0.f;
          wsa[e] = (bf16)(pk2(a, 0.f) & 0xffffu); wsb[e] = (bf16)(pk2(b, 0.f) & 0xffffu); } }
    { const float* w_pool = in[16]; bf16* wpt = (bf16*)(ws + WS_WPT);
      for (int e = gt; e < 4 * 256 * 256; e += ngt) { const int g = e >> 16, d = (e >> 8) & 255, c = e & 255;
          wpt[e] = (bf16)(pk2(w_pool[(g * 256 + c) * 256 + d], 0.f) & 0xffffu); } }
    { float* COS = (float*)(ws + WS_COS); float* SIN = (float*)(ws + WS_SIN);
      for (int e = gt; e < 8192 * 128; e += ngt) { const int pos = e >> 7, ch = e & 127;
          const float freq = powf(10000.0f, -(float)ch / 128.0f); const float ang = (float)pos * freq;
          COS[e] = cosf(ang); SIN[e] = sinf(ang); } }
}

__device__ __forceinline__ void ph_norm(const float* xP, const float* xS, const float* g, const float* shiftb, const float* scaleb, bf16* H,
                                        const float* part, int KS, const float* gate, float* Xout) {
    const int lane = threadIdx.x & 63, gw = blockIdx.x * 8 + (threadIdx.x >> 6), ngw = gridDim.x * 8;
    for (int row = gw; row < M; row += ngw) {
        const f32x4* xr = (const f32x4*)(row < MP ? xP + (size_t)row * D : xS + (size_t)(row - MP) * D) + lane;
        const int bi = row_bi(row);
        f32x4 v[8];
#pragma unroll
        for (int j = 0; j < 8; ++j) v[j] = xr[64 * j];
        if (part && row >= MP) {
            f32x4 sacc[8];
#pragma unroll
            for (int j = 0; j < 8; ++j) sacc[j] = (f32x4){0.f, 0.f, 0.f, 0.f};
            for (int ks = 0; ks < KS; ++ks) { const f32x4* pp = (const f32x4*)(part + ((size_t)ks * MS + (row - MP)) * D) + lane;
#pragma unroll
                for (int j = 0; j < 8; ++j) sacc[j] += pp[64 * j]; }
            const f32x4* gt = (const f32x4*)(gate + (size_t)bi * NMOD) + lane; f32x4* xo = (f32x4*)(Xout + (size_t)row * D) + lane;
#pragma unroll
            for (int j = 0; j < 8; ++j) { v[j] += gt[64 * j] * sacc[j]; xo[64 * j] = v[j]; }
        }
        float s = 0.f;
#pragma unroll
        for (int j = 0; j < 8; ++j) s += (v[j].x * v[j].x + v[j].y * v[j].y) + (v[j].z * v[j].z + v[j].w * v[j].w);
        const float r = 1.0f / sqrtf(wave_sum(s) * (1.0f / D) + EPS);
        const f32x4* gp = (const f32x4*)g + lane; const f32x4* sh = (const f32x4*)(shiftb + (size_t)bi * NMOD) + lane; const f32x4* sc = (const f32x4*)(scaleb + (size_t)bi * NMOD) + lane;
        u32x2* o = (u32x2*)(H + (size_t)row * D) + lane;
#pragma unroll
        for (int j = 0; j < 8; ++j) { const f32x4 y = v[j] * r * gp[64 * j] * (1.0f + sc[64 * j]) + sh[64 * j]; u32x2 w; w.x = pk2(y.x, y.y); w.y = pk2(y.z, y.w); o[64 * j] = w; }
    }
}
__device__ __forceinline__ void ph_final_norm(float* X, const float* g, const float* part, int KS, const float* gate) {
    const int lane = threadIdx.x & 63, gw = blockIdx.x * 8 + (threadIdx.x >> 6), ngw = gridDim.x * 8;
    for (int row = gw; row < M; row += ngw) {
        f32x4* xr = (f32x4*)(X + (size_t)row * D) + lane;
        f32x4 v[8];
#pragma unroll
        for (int j = 0; j < 8; ++j) v[j] = xr[64 * j];
        if (row >= MP) {
            f32x4 sacc[8];
#pragma unroll
            for (int j = 0; j < 8; ++j) sacc[j] = (f32x4){0.f, 0.f, 0.f, 0.f};
            for (int ks = 0; ks < KS; ++ks) { const f32x4* pp = (const f32x4*)(part + ((size_t)ks * MS + (row - MP)) * D) + lane;
#pragma unroll
                for (int j = 0; j < 8; ++j) sacc[j] += pp[64 * j]; }
            const f32x4* gt = (const f32x4*)(gate + (size_t)row_bi(row) * NMOD) + lane;
#pragma unroll
            for (int j = 0; j < 8; ++j) v[j] += gt[64 * j] * sacc[j];
        }
        float s = 0.f;
#pragma unroll
        for (int j = 0; j < 8; ++j) s += (v[j].x * v[j].x + v[j].y * v[j].y) + (v[j].z * v[j].z + v[j].w * v[j].w);
        const float r = 1.0f / sqrtf(wave_sum(s) * (1.0f / D) + EPS);
        const f32x4* gp = (const f32x4*)g + lane;
#pragma unroll
        for (int j = 0; j < 8; ++j) xr[64 * j] = v[j] * r * gp[64 * j];
    }
}

__device__ __forceinline__ void ph_mixer(const float* const* in, unsigned char* ws, float* out, LAS unsigned char* lds) {
    const int tid = threadIdx.x, lane = tid & 63, wave = tid >> 6, fr = lane & 15, fq = lane >> 4;
    const bf16* U = (const bf16*)(ws + WS_R + R_U); const bf16* V = (const bf16*)(ws + WS_R + R_V); const bf16* XB = (const bf16*)(ws + WS_R + R_XB);
    bf16* CAT = (bf16*)(ws + WS_H);
    const float* ln_g = in[12]; const float* ln_b = in[13]; const float* b_s = in[15]; const float* pool_scale = in[17]; const float* hist = in[4];
    float* vs_out = out + OUT_VS;
    for (int unit = blockIdx.x; unit < 512 + 64; unit += gridDim.x) {
        const bool subu = unit >= 512; const int su = unit - 512;
        const int blk = subu ? 128 + (su >> 4) : unit >> 2, part = subu ? (su >> 2) & 3 : unit & 3, sub = su & 3;
        const int gi_lo = subu ? (part < 2 ? sub : sub >> 1) : 0, gi_hi = subu ? gi_lo + 1 : (part < 2 ? 4 : 2), dh_lo = subu ? (sub & 1) : 0, dh_hi = subu ? dh_lo + 1 : 2;
        const bool samp = blk >= 128;
        const int R0 = samp ? MP + (blk - 128) * 128 : blk * 128;
        if (part < 2) {
            LAS float* stat = (LAS float*)lds;
            LAS bf16* As = (LAS bf16*)(lds + 1024);
            LAS bf16* Bs = (LAS bf16*)(lds + 1024 + 34816);
            __syncthreads();
            for (int r = 0; r < 16; ++r) {
                const int t = wave * 16 + r;
                const u32x4* vp = (const u32x4*)(V + (size_t)(R0 + t) * 1024) + lane * 2;
                float f[16]; { float a[8], b[8]; unpack8(vp[0], a); unpack8(vp[1], b);
#pragma unroll
                    for (int j = 0; j < 8; ++j) { f[j] = a[j]; f[8 + j] = b[j]; } }
                float s = 0.f;
#pragma unroll
                for (int j = 0; j < 16; ++j) s += f[j];
                const float mean = wave_sum(s) * (1.0f / 1024.0f); float q = 0.f;
#pragma unroll
                for (int j = 0; j < 16; ++j) { const float d = f[j] - mean; q += d * d; }
                const float rstd = 1.0f / sqrtf(wave_sum(q) * (1.0f / 1024.0f) + EPS);
                if (lane == 0) { stat[2 * t] = mean; stat[2 * t + 1] = rstd; }
            }
            const bf16* wsrc = (const bf16*)(ws + (samp ? WS_WSB : WS_WSA));
            for (int gi = gi_lo; gi < gi_hi; ++gi) {
                const int g = part * 4 + gi;
                __syncthreads();
#pragma unroll
                for (int i = 0; i < 4; ++i) { const int e = tid + 512 * i, row = e >> 4, cc = e & 15;
                    *(LAS u32x4*)(As + row * 136 + cc * 8) = *(const u32x4*)(wsrc + (size_t)(g * 128 + row) * 128 + cc * 8); }
#pragma unroll
                for (int i = 0; i < 4; ++i) { const int e = tid + 512 * i, s = e >> 4, c8 = e & 15;
                    float f[8]; unpack8(*(const u32x4*)(V + (size_t)(R0 + s) * 1024 + g * 128 + c8 * 8), f);
                    const float mean = stat[2 * s], rstd = stat[2 * s + 1];
                    const f32x4 g0 = *(const f32x4*)(ln_g + g * 128 + c8 * 8), g1 = *(const f32x4*)(ln_g + g * 128 + c8 * 8 + 4);
                    const f32x4 b0 = *(const f32x4*)(ln_b + g * 128 + c8 * 8), b1 = *(const f32x4*)(ln_b + g * 128 + c8 * 8 + 4);
#pragma unroll
                    for (int j = 0; j < 4; ++j) { f[j] = (f[j] - mean) * rstd * g0[j] + b0[j]; f[4 + j] = (f[4 + j] - mean) * rstd * g1[j] + b1[j]; }
                    if (samp) { float* vo = vs_out + (size_t)(R0 - MP + s) * 1024 + g * 128 + c8 * 8;
                        *(f32x4*)vo = (f32x4){f[0], f[1], f[2], f[3]}; *(f32x4*)(vo + 4) = (f32x4){f[4], f[5], f[6], f[7]}; }
#pragma unroll
                    for (int j = 0; j < 8; j += 2) { const unsigned w = pk2(f[j], f[j + 1]); Bs[(c8 * 8 + j) * 136 + s] = (bf16)(w & 0xffffu); Bs[(c8 * 8 + j + 1) * 136 + s] = (bf16)(w >> 16); }
                }
                __syncthreads();
                f32x4 acc[8];
#pragma unroll
                for (int ct = 0; ct < 8; ++ct) acc[ct] = (f32x4){0.f, 0.f, 0.f, 0.f};
#pragma unroll
                for (int ks = 0; ks < 4; ++ks) {
                    const bf16x8 a = *(const LAS bf16x8*)(As + (wave * 16 + fr) * 136 + ks * 32 + fq * 8);
#pragma unroll
                    for (int ct = 0; ct < 8; ++ct) { const bf16x8 b = *(const LAS bf16x8*)(Bs + (ct * 16 + fr) * 136 + ks * 32 + fq * 8); acc[ct] = MFMA16(b, a, acc[ct]); }
                }
                {
                    LAS float* Ew = (LAS float*)(lds + 1024 + 2 * 34816) + wave * (16 * 132);
                    const int t = wave * 16 + fr; const float bsv = b_s[g * 128 + (samp ? (t & 31) : t)];
#pragma unroll
                    for (int ct = 0; ct < 8; ++ct) *(LAS f32x4*)(Ew + fr * 132 + ct * 16 + 4 * fq) = acc[ct] + bsv;
#pragma unroll
                    for (int it = 0; it < 4; ++it) { const int rr = it * 4 + (lane >> 4), c0 = (lane & 15) * 8, tt = wave * 16 + rr;
                        const f32x4 m0 = *(const LAS f32x4*)(Ew + rr * 132 + c0), m1 = *(const LAS f32x4*)(Ew + rr * 132 + c0 + 4);
                        float uf[8]; unpack8(*(const u32x4*)(U + (size_t)(R0 + tt) * 1024 + g * 128 + c0), uf);
                        float o[8] = {uf[0] * m0[0], uf[1] * m0[1], uf[2] * m0[2], uf[3] * m0[3], uf[4] * m1[0], uf[5] * m1[1], uf[6] * m1[2], uf[7] * m1[3]};
                        *(u32x4*)(CAT + (size_t)(R0 + tt) * D + g * 128 + c0) = pack8(o); }
                }
            }
        } else {
            LAS bf16* As = (LAS bf16*)lds;
            LAS bf16* Bs = (LAS bf16*)(lds + 67584);
            const bf16* WPT = (const bf16*)(ws + WS_WPT);
            for (int gi = gi_lo; gi < gi_hi; ++gi) {
                const int g = (part - 2) * 2 + gi, w = 2 << g;
                __syncthreads();
                {
                    const int tl = tid >> 5, co = tid & 31, t0 = tl * 8, cb = g * 256 + co * 8;
                    int sb = 0, i0 = 0, p0 = 0;
                    if (samp) { sb = (blk - 128) * 4 + (t0 >> 5); i0 = t0 & 31; } else { p0 = (R0 & 8191) + t0; }
                    auto ldrow = [&](int dt, float (&f)[8]) {
                        if (samp) { const int i = i0 + dt;
                            if (i >= 0) unpack8(*(const u32x4*)(XB + (size_t)(R0 + t0 + dt) * 1024 + cb), f);
                            else { const float* hp = hist + ((size_t)sb * 15 + (15 + i)) * 1024 + cb; const f32x4 a = *(const f32x4*)hp, b = *(const f32x4*)(hp + 4);
                                f[0] = a.x; f[1] = a.y; f[2] = a.z; f[3] = a.w; f[4] = b.x; f[5] = b.y; f[6] = b.z; f[7] = b.w; } }
                        else { if (p0 + dt >= 0) unpack8(*(const u32x4*)(XB + (size_t)(R0 + t0 + dt) * 1024 + cb), f);
                            else {
#pragma unroll
                                for (int j = 0; j < 8; ++j) f[j] = 0.f; } }
                    };
                    float S[8], x[8], y[8];
#pragma unroll
                    for (int j = 0; j < 8; ++j) S[j] = 0.f;
                    for (int j = 1; j < w; ++j) { ldrow(-j, x);
#pragma unroll
                        for (int q = 0; q < 8; ++q) S[q] += x[q]; }
                    for (int tt = 0; tt < 8; ++tt) {
                        ldrow(tt, x);
#pragma unroll
                        for (int q = 0; q < 8; ++q) S[q] += x[q];
                        const int pos = samp ? 2048 + i0 + tt : p0 + tt; const float inv = 1.0f / (float)(w < pos + 1 ? w : pos + 1);
                        float pv[8];
#pragma unroll
                        for (int q = 0; q < 8; ++q) pv[q] = S[q] * inv - x[q];
                        *(LAS u32x4*)(As + (t0 + tt) * 264 + co * 8) = pack8(pv);
                        ldrow(tt - w + 1, y);
#pragma unroll
                        for (int q = 0; q < 8; ++q) S[q] -= y[q];
                    }
                }
                for (int dh = dh_lo; dh < dh_hi; ++dh) {
                    __syncthreads();
#pragma unroll
                    for (int i = 0; i < 8; ++i) { const int e = tid + 512 * i, d = e >> 5, c8 = e & 31;
                        *(LAS u32x4*)(Bs + d * 264 + c8 * 8) = *(const u32x4*)(WPT + (size_t)(g * 256 + dh * 128 + d) * 256 + c8 * 8); }
                    __syncthreads();
                    f32x4 acc[8];
#pragma unroll
                    for (int ct = 0; ct < 8; ++ct) acc[ct] = (f32x4){0.f, 0.f, 0.f, 0.f};
#pragma unroll
                    for (int ks = 0; ks < 8; ++ks) {
                        const bf16x8 a = *(const LAS bf16x8*)(As + (wave * 16 + fr) * 264 + ks * 32 + fq * 8);
#pragma unroll
                        for (int ct = 0; ct < 8; ++ct) { const bf16x8 b = *(const LAS bf16x8*)(Bs + (ct * 16 + fr) * 264 + ks * 32 + fq * 8); acc[ct] = MFMA16(b, a, acc[ct]); }
                    }
                    __syncthreads();
                    {
                        LAS float* Ew = (LAS float*)(lds + 67584) + wave * (16 * 132);
#pragma unroll
                        for (int ct = 0; ct < 8; ++ct) *(LAS f32x4*)(Ew + fr * 132 + ct * 16 + 4 * fq) = acc[ct];
#pragma unroll
                        for (int it = 0; it < 4; ++it) { const int rr = it * 4 + (lane >> 4), c0 = (lane & 15) * 8, tt = wave * 16 + rr, dcol = g * 256 + dh * 128 + c0;
                            const f32x4 m0 = *(const LAS f32x4*)(Ew + rr * 132 + c0), m1 = *(const LAS f32x4*)(Ew + rr * 132 + c0 + 4);
                            const f32x4 p0 = *(const f32x4*)(pool_scale + dcol), p1 = *(const f32x4*)(pool_scale + dcol + 4);
                            float o[8] = {m0[0] * p0[0], m0[1] * p0[1], m0[2] * p0[2], m0[3] * p0[3], m1[0] * p1[0], m1[1] * p1[1], m1[2] * p1[2], m1[3] * p1[3]};
                            *(u32x4*)(CAT + (size_t)(R0 + tt) * D + 1024 + dcol) = pack8(o); }
                    }
                }
            }
        }
    }
}
template <int L> __device__ __forceinline__ void scores_unit(const bf16* Q, const bf16* K, bf16* P, int row0, int h, int lane) {
    constexpr int NT = L / 16; const int fr = lane & 15, fq = lane >> 4;
    const float sc = exp2f(-(float)L * head_log_g(h) * 1.4426950408889634f);
    for (int lt = 0; lt < NT; ++lt) {
        f32x4 acc[NT];
#pragma unroll
        for (int mt = 0; mt < NT; ++mt) acc[mt] = (f32x4){0.f, 0.f, 0.f, 0.f};
#pragma unroll
        for (int ks = 0; ks < 8; ++ks) {
            const bf16x8 a = *(const bf16x8*)(Q + (((size_t)(row0 >> 4) + lt) * 8 + ks) * 512 + lane * 8);
#pragma unroll
            for (int mt = 0; mt < NT; ++mt) { const bf16x8 b = *(const bf16x8*)(K + (size_t)(row0 + mt * 16 + fr) * 256 + ks * 32 + fq * 8); acc[mt] = MFMA16(b, a, acc[mt]); }
        }
        const int l = lt * 16 + fr;
#pragma unroll
        for (int mt = 0; mt < NT; ++mt) { const int m0 = mt * 16 + 4 * fq; float v[4];
#pragma unroll
            for (int r = 0; r < 4; ++r) v[r] = (l >= m0 + r) ? acc[mt][r] * sc : 0.f;
            u32x2 o; o.x = pk2(v[0], v[1]); o.y = pk2(v[2], v[3]);
            if (L == 64) *(u32x2*)(P + ((lt * 2 + (mt >> 1)) * 64 + ((mt & 1) * 2 + (fq >> 1)) * 16 + fr) * 8 + (fq & 1) * 4) = o;
            else *(u32x2*)(P + l * L + m0) = o; }
    }
}
__device__ __forceinline__ void ph_scores(unsigned char* ws) {
    const int lane = threadIdx.x & 63, gw = blockIdx.x * 8 + (threadIdx.x >> 6), ngw = gridDim.x * 8;
    const bf16* Q = (const bf16*)(ws + WS_R + R_Q); const bf16* K = (const bf16*)(ws + WS_R + R_K);
    for (int unit = gw; unit < 2048 + 128; unit += ngw) {
        if (unit < 2048) scores_unit<64>(Q, K, (bf16*)(ws + WS_PP) + (size_t)unit * 4096, hm_row((unit >> 3) * 64, unit & 7), unit & 7, lane);
        else { const int su = unit - 2048; scores_unit<32>(Q, K, (bf16*)(ws + WS_PS) + (size_t)su * 1024, hm_row(MP + (su >> 3) * 32, su & 7), su & 7, lane); }
    }
}

constexpr int RQP = 272, RVP = 80, RPP = 72;
constexpr int R_QS = 0, R_KS = R_QS + 64 * RQP * 2, R_VS = R_KS + 64 * RQP * 2, R_PS = R_VS + 64 * RVP * 2, R_ST = R_PS + 64 * RPP * 2, R_LDS_END = R_ST + 64 * RQP * 2;
static_assert(R_LDS_END <= 131072, "retention LDS");
__device__ __forceinline__ bf16x8 tr_frag(const LAS bf16* base, int pitch) {
    const s16x4 lo = __builtin_amdgcn_ds_read_tr16_b64_v4i16((LAS s16x4*)(base)), hi = __builtin_amdgcn_ds_read_tr16_b64_v4i16((LAS s16x4*)(base + 4 * pitch));
    return (bf16x8){lo[0], lo[1], lo[2], lo[3], hi[0], hi[1], hi[2], hi[3]};
}
template <int L> __device__ __forceinline__ void ret_unit(const bf16* Qd, const bf16* Kd, const bf16* Vv, const bf16* P, size_t pstride, bf16* O, int row0, int nchunks, int h, int e0,
                                                         const float* S0, float* Sout, LAS unsigned char* lds) {
    const int tid = threadIdx.x, lane = tid & 63, wave = tid >> 6, fr = lane & 15, fq = lane >> 4, tq = (lane & 15) >> 2, tp = lane & 3;
    LAS bf16* Qs = (LAS bf16*)(lds + R_QS); LAS bf16* Ks = (LAS bf16*)(lds + R_KS); LAS bf16* Vs = (LAS bf16*)(lds + R_VS); LAS bf16* Ps = (LAS bf16*)(lds + R_PS); LAS bf16* ST = (LAS bf16*)(lds + R_ST);
    constexpr int NQ = L / 16, TPW = L / 32, NKS = L / 32;
    constexpr bool VALL = (L == 64);
    const float gL = exp2f((float)L * head_log_g(h) * 1.4426950408889634f);
    f32x4 S[2][4];
#pragma unroll
    for (int dti = 0; dti < 2; ++dti)
#pragma unroll
        for (int et = 0; et < 4; ++et)
#pragma unroll
            for (int r = 0; r < 4; ++r) S[dti][et][r] = S0 ? S0[(size_t)((2 * wave + dti) * 16 + 4 * fq + r) * 512 + e0 + et * 16 + fr] : 0.f;
    u32x4 rq[NQ], rk[NQ], rv, rp;
    rv = (u32x4){0u, 0u, 0u, 0u}; rp = rv;
    const bool vact = VALL || tid < 8 * L, pact = tid < L * (L / 8);
#define RET_LOAD(c) do { const size_t rb = (size_t)row0 + (size_t)(c) * L; \
        _Pragma("unroll") for (int i = 0; i < NQ; ++i) { const int e = tid + 512 * i, r = e >> 5, pc = e & 31; \
            rq[i] = *(const u32x4*)(Qd + rb * 256 + (size_t)e * 8); rk[i] = *(const u32x4*)(Kd + (rb + r) * 256 + pc * 8); } \
        if (vact) rv = *(const u32x4*)(Vv + (rb + (tid >> 3)) * 512 + e0 + (tid & 7) * 8); \
        if (pact) rp = *(const u32x4*)(P + (size_t)(c) * pstride + (size_t)(tid / (L / 8)) * L + (tid % (L / 8)) * 8); } while (0)
    RET_LOAD(0);
    for (int c = 0; c < nchunks; ++c) {
        __syncthreads();
#pragma unroll
        for (int i = 0; i < NQ; ++i) { const int e = tid + 512 * i, r = e >> 5, pc = e & 31; *(LAS u32x4*)(Qs + ((e >> 9) * 16 + (e & 15)) * RQP + ((e >> 6) & 7) * 32 + ((e >> 4) & 3) * 8) = rq[i]; *(LAS u32x4*)(Ks + r * RQP + pc * 8) = rk[i]; }
        if (vact) *(LAS u32x4*)(Vs + (tid >> 3) * RVP + (tid & 7) * 8) = rv;
        if (pact) *(LAS u32x4*)(Ps + (tid / (L / 8)) * RPP + (tid % (L / 8)) * 8) = rp;
#pragma unroll
        for (int dti = 0; dti < 2; ++dti)
#pragma unroll
            for (int et = 0; et < 4; ++et) { u32x2 w; w.x = pk2(S[dti][et][0], S[dti][et][1]); w.y = pk2(S[dti][et][2], S[dti][et][3]);
                *(LAS u32x2*)(ST + (et * 16 + fr) * RQP + (2 * wave + dti) * 16 + 4 * fq) = w; }
        __syncthreads();
        if (c + 1 < nchunks) RET_LOAD(c + 1);
#pragma unroll
        for (int i = 0; i < TPW; ++i) {
            const int t = wave * TPW + i, lt = t >> 2, et = t & 3;
            f32x4 o = (f32x4){0.f, 0.f, 0.f, 0.f};
#pragma unroll
            for (int ks = 0; ks < 8; ++ks) { const bf16x8 a = *(const LAS bf16x8*)(Qs + (lt * 16 + fr) * RQP + ks * 32 + fq * 8), b = *(const LAS bf16x8*)(ST + (et * 16 + fr) * RQP + ks * 32 + fq * 8); o = MFMA16(b, a, o); }
#pragma unroll
            for (int ks = 0; ks < NKS; ++ks) { const bf16x8 a = *(const LAS bf16x8*)(Ps + (lt * 16 + fr) * RPP + ks * 32 + fq * 8), b = tr_frag(Vs + (ks * 32 + 8 * fq + tq) * RVP + et * 16 + 4 * tp, RVP); o = MFMA16(b, a, o); }
            u32x2 w; w.x = pk2(o[0], o[1]); w.y = pk2(o[2], o[3]);
            *(u32x2*)(O + ((size_t)row0 + (size_t)c * L + lt * 16 + fr) * 512 + e0 + et * 16 + 4 * fq) = w;
        }
#pragma unroll
        for (int dti = 0; dti < 2; ++dti)
#pragma unroll
            for (int et = 0; et < 4; ++et) S[dti][et] = S[dti][et] * gL;
#pragma unroll
        for (int ks = 0; ks < NKS; ++ks) {
            bf16x8 bv[4];
#pragma unroll
            for (int et = 0; et < 4; ++et) bv[et] = tr_frag(Vs + (ks * 32 + 8 * fq + tq) * RVP + et * 16 + 4 * tp, RVP);
#pragma unroll
            for (int dti = 0; dti < 2; ++dti) { const bf16x8 ak = tr_frag(Ks + (ks * 32 + 8 * fq + tq) * RQP + (2 * wave + dti) * 16 + 4 * tp, RQP);
#pragma unroll
                for (int et = 0; et < 4; ++et) S[dti][et] = MFMA16(ak, bv[et], S[dti][et]); }
        }
    }
#undef RET_LOAD
#pragma unroll
    for (int dti = 0; dti < 2; ++dti)
#pragma unroll
        for (int et = 0; et < 4; ++et)
#pragma unroll
            for (int r = 0; r < 4; ++r) Sout[(size_t)((2 * wave + dti) * 16 + 4 * fq + r) * 512 + e0 + et * 16 + fr] = S[dti][et][r];
}

constexpr int P_KB = 0, P_VB = 2 * 64 * RQP * 2, P_VP = 48, P_ST = P_VB + 2 * 64 * P_VP * 2, P_END = P_ST + 2 * 32 * RQP * 2;
static_assert(P_END <= 131072, "prompt retention LDS");
template <int VAR> __device__ __forceinline__ void ret_prompt(const bf16* Qd, const bf16* Kd, const bf16* Vv, const bf16* P, bf16* O, int row0, int h, int e0, float* Sout, LAS unsigned char* lds) {
    const int tid = threadIdx.x, lane = tid & 63, wave = tid >> 6, fr = lane & 15, fq = lane >> 4, tq = (lane & 15) >> 2, tp = lane & 3;
    constexpr int NCH = 128;
    const float gL = exp2f(64.0f * head_log_g(h) * 1.4426950408889634f);
    const int lt = wave >> 1, et_o = wave & 1;
    f32x4 S[2][2];
#pragma unroll
    for (int a = 0; a < 2; ++a)
#pragma unroll
        for (int b = 0; b < 2; ++b) S[a][b] = (f32x4){0.f, 0.f, 0.f, 0.f};
    u32x4 rkA[4], rkB[4], rvA, rvB; rvA = (u32x4){0u, 0u, 0u, 0u}; rvB = rvA;
    bf16x8 qA[8], qB[8], pA[2], pB[2];
    const char* kbase = (const char*)(Kd + (size_t)row0 * 256); const char* vbase = (const char*)(Vv + (size_t)row0 * 512 + e0);
    const char* qbase = (const char*)(Qd + (size_t)row0 * 256); const char* pbase = (const char*)P; char* obase = (char*)(O + (size_t)row0 * 512 + e0);
    unsigned koff[4];
#pragma unroll
    for (int i = 0; i < 4; ++i) { const int e = tid + 512 * i; koff[i] = (unsigned)(e * 16); }
    const unsigned voff = (unsigned)((((tid & 255) >> 2) * 512 + (tid & 3) * 8) * 2), qoff = (unsigned)((lt * 8 * 512 + lane * 8) * 2), poff = (unsigned)((lt * 2 * 512 + lane * 8) * 2);
    const unsigned ooff = (unsigned)(((lt * 16 + fr) * 512 + et_o * 16 + 4 * fq) * 2);
    unsigned klds[4];
#pragma unroll
    for (int i = 0; i < 4; ++i) { const int e = tid + 512 * i; klds[i] = (unsigned)(P_KB + ((e >> 5) * RQP + (e & 31) * 8) * 2); }
    const unsigned vlds = (unsigned)(P_VB + (((tid & 255) >> 2) * P_VP + (tid & 3) * 8) * 2);
#define RP_LOADKV(rk, rv, c) do { const char* kc_ = kbase + (size_t)(c) * (64 * 256 * 2); const char* vc_ = vbase + (size_t)(c) * (64 * 512 * 2); \
        _Pragma("unroll") for (int i = 0; i < 4; ++i) rk[i] = *(const u32x4*)(kc_ + koff[i]); rv = *(const u32x4*)(vc_ + voff); } while (0)
#define RP_STOREKV(rk, rv, b) do { _Pragma("unroll") for (int i = 0; i < 4; ++i) *(LAS u32x4*)(lds + (b) * (64 * RQP * 2) + klds[i]) = rk[i]; \
        *(LAS u32x4*)(lds + (b) * (64 * P_VP * 2) + vlds) = rv; } while (0)
#define RP_LOADQP(dq, dp, c) do { const char* qc_ = qbase + (size_t)(c) * (64 * 256 * 2) + qoff; const char* pc_ = pbase + (size_t)(c) * (8 * 4096 * 2) + poff; \
        _Pragma("unroll") for (int ks = 0; ks < 8; ++ks) dq[ks] = *(const bf16x8*)(qc_ + ks * 1024); \
        _Pragma("unroll") for (int ks = 0; ks < 2; ++ks) dp[ks] = *(const bf16x8*)(pc_ + ks * 1024); } while (0)
#define RP_STOREST(b) do { _Pragma("unroll") for (int dti = 0; dti < 2; ++dti) _Pragma("unroll") for (int et = 0; et < 2; ++et) { u32x2 w; w.x = pk2(S[dti][et][0], S[dti][et][1]); w.y = pk2(S[dti][et][2], S[dti][et][3]); \
        *(LAS u32x2*)(lds + P_ST + (b) * (32 * RQP * 2) + ((et * 16 + fr) * RQP + (2 * wave + dti) * 16 + 4 * fq) * 2) = w; } } while (0)
#define RP_BODY(c, cur, rkX, rvX, qX, pX) do { \
        asm volatile("s_waitcnt lgkmcnt(0)" ::: "memory"); __builtin_amdgcn_s_barrier(); asm volatile("" ::: "memory"); \
        RP_STOREKV(rkX, rvX, (cur) ^ 1); \
        if (VAR != 2) { const int ck = (c) + 3 < NCH ? (c) + 3 : NCH - 1; RP_LOADKV(rkX, rvX, ck); } \
        const LAS bf16* Kc = (const LAS bf16*)(lds + P_KB + (cur) * (64 * RQP * 2)); const LAS bf16* Vc = (const LAS bf16*)(lds + P_VB + (cur) * (64 * P_VP * 2)); \
        const LAS bf16* STp = (const LAS bf16*)(lds + P_ST + ((cur) ^ 1) * (32 * RQP * 2)); \
        bf16x8 bv[2][2], sb[4]; \
        _Pragma("unroll") for (int ks = 0; ks < 2; ++ks) _Pragma("unroll") for (int et = 0; et < 2; ++et) bv[ks][et] = tr_frag(Vc + (ks * 32 + 8 * fq + tq) * P_VP + et * 16 + 4 * tp, P_VP); \
        _Pragma("unroll") for (int a = 0; a < 2; ++a) _Pragma("unroll") for (int b = 0; b < 2; ++b) S[a][b] = S[a][b] * gL; \
        _Pragma("unroll") for (int ks = 0; ks < 2; ++ks) { bf16x8 ak[2]; \
          _Pragma("unroll") for (int dti = 0; dti < 2; ++dti) ak[dti] = tr_frag(Kc + (ks * 32 + 8 * fq + tq) * RQP + (2 * wave + dti) * 16 + 4 * tp, RQP); \
          _Pragma("unroll") for (int dti = 0; dti < 2; ++dti) _Pragma("unroll") for (int et = 0; et < 2; ++et) S[dti][et] = MFMA16(ak[dti], bv[ks][et], S[dti][et]); } \
        _Pragma("unroll") for (int ks = 0; ks < 4; ++ks) sb[ks] = *(const LAS bf16x8*)(STp + (et_o * 16 + fr) * RQP + ks * 32 + fq * 8); \
        RP_STOREST(cur); \
        { f32x4 o0 = (f32x4){0.f, 0.f, 0.f, 0.f}, o1 = o0; \
          o0 = MFMA16(sb[0], qX[0], o0); o1 = MFMA16(sb[1], qX[1], o1); o0 = MFMA16(sb[2], qX[2], o0); o1 = MFMA16(sb[3], qX[3], o1); \
          _Pragma("unroll") for (int ks = 0; ks < 4; ++ks) sb[ks] = *(const LAS bf16x8*)(STp + (et_o * 16 + fr) * RQP + (4 + ks) * 32 + fq * 8); \
          { const bf16x8 bo0 = tr_frag(Vc + (8 * fq + tq) * P_VP + et_o * 16 + 4 * tp, P_VP), bo1 = tr_frag(Vc + (32 + 8 * fq + tq) * P_VP + et_o * 16 + 4 * tp, P_VP); \
            o0 = MFMA16(bo0, pX[0], o0); o1 = MFMA16(bo1, pX[1], o1); } \
          o0 = MFMA16(sb[0], qX[4], o0); o1 = MFMA16(sb[1], qX[5], o1); o0 = MFMA16(sb[2], qX[6], o0); o1 = MFMA16(sb[3], qX[7], o1); \
          const f32x4 o = o0 + o1; u32x2 w; w.x = pk2(o[0], o[1]); w.y = pk2(o[2], o[3]); \
          if (VAR != 4) *(u32x2*)(obase + (size_t)(c) * (64 * 512 * 2) + ooff) = w; else if (o[0] == 123.456f) *(u32x2*)(obase + ooff) = w; } \
        if (VAR != 1) { const int cq = (c) + 2 < NCH ? (c) + 2 : NCH - 1; RP_LOADQP(qX, pX, cq); } \
        } while (0)
    __syncthreads();
    RP_LOADKV(rkA, rvA, 0); RP_STOREKV(rkA, rvA, 0); RP_STOREST(1);
    RP_LOADKV(rkA, rvA, 1); RP_LOADKV(rkB, rvB, 2); RP_LOADQP(qA, pA, 0); RP_LOADQP(qB, pB, 1);
#pragma nounroll
    for (int c = 0; c < NCH; c += 2) {
        RP_BODY(c, 0, rkA, rvA, qA, pA);
        __builtin_amdgcn_sched_barrier(0);
        RP_BODY(c + 1, 1, rkB, rvB, qB, pB);
        __builtin_amdgcn_sched_barrier(0);
    }
#undef RP_BODY
#undef RP_LOADKV
#undef RP_STOREKV
#undef RP_LOADQP
#undef RP_STOREST
#pragma unroll
    for (int dti = 0; dti < 2; ++dti)
#pragma unroll
        for (int et = 0; et < 2; ++et)
#pragma unroll
            for (int r = 0; r < 4; ++r) Sout[(size_t)((2 * wave + dti) * 16 + 4 * fq + r) * 512 + e0 + et * 16 + fr] = S[dti][et][r];
}
__device__ __forceinline__ void ph_retention(const float* const* in, unsigned char* ws, float* out, LAS unsigned char* lds) {
    const bf16* Q = (const bf16*)(ws + WS_R + R_Q); const bf16* K = (const bf16*)(ws + WS_R + R_K); const bf16* V = (const bf16*)(ws + WS_R + R_VV); bf16* O = (bf16*)(ws + WS_R + R_O);
#if DUP_PHASE >= 200
    for (int task = blockIdx.x; task < 256; task += gridDim.x) {
        const int xcd = task & 7, idx = task >> 3, bh = xcd * 2 + (idx >> 4), sl = idx & 15, b = bh >> 3, h = bh & 7;
        ret_prompt<DUP_PHASE - 200>(Q, K, V, (const bf16*)(ws + WS_PP) + ((size_t)(b * 128) * 8 + h) * 4096, (bf16*)(ws + WS_H) - (size_t)bh * SEQ * 512, bh * SEQ, h, sl * 32, (float*)(ws + WS_H + (16u << 20)), lds);
    }
    __syncthreads();
#endif
    for (int task = blockIdx.x; task < 256; task += gridDim.x) {
        const int xcd = task & 7, idx = task >> 3, bh = xcd * 2 + (idx >> 4), sl = idx & 15, b = bh >> 3, h = bh & 7;
        ret_prompt<0>(Q, K, V, (const bf16*)(ws + WS_PP) + ((size_t)(b * 128) * 8 + h) * 4096, O, bh * SEQ, h, sl * 32, out + OUT_RETP + (size_t)bh * 256 * 512, lds);
    }
#if DUP_PHASE == 111
    for (int rep_ = 0; rep_ < 2; ++rep_)
#endif
    for (int task = blockIdx.x; task < 256; task += gridDim.x) {
        const int su = task >> 1, sb = su >> 3, h = su & 7;
        for (int sl = (task & 1) * 4; sl < (task & 1) * 4 + 4; ++sl)
            ret_unit<32>(Q, K, V, (const bf16*)(ws + WS_PS) + (size_t)su * 1024, 0, O, MP * 8 + su * 32, 1, h, sl * 64, in[5] + (size_t)su * 256 * 512, out + OUT_RETS + (size_t)su * 256 * 512, lds);
    }
}
__device__ __forceinline__ void ph_gate_norm(unsigned char* ws) {
    const int lane = threadIdx.x & 63, gw = blockIdx.x * 8 + (threadIdx.x >> 6), ngw = gridDim.x * 8;
    bf16* G = (bf16*)(ws + WS_R + R_G); const bf16* O = (const bf16*)(ws + WS_R + R_O);
    for (int row = gw; row < M; row += ngw) {
#pragma unroll
        for (int hh = 0; hh < 8; ++hh) {
            const size_t off = (size_t)row * VW + hh * 512 + lane * 8, ooff = (size_t)hm_row(row, hh) * 512 + lane * 8;
            float o[8], g[8]; unpack8(*(const u32x4*)(O + ooff), o); unpack8(*(const u32x4*)(G + off), g);
            float s = 0.f;
#pragma unroll
            for (int j = 0; j < 8; ++j) s += o[j] * o[j];
            const float r = 1.0f / sqrtf(wave_sum(s) * (1.0f / 512.0f) + EPS);
#pragma unroll
            for (int j = 0; j < 8; ++j) g[j] = g[j] * o[j] * r;
            *(u32x4*)(G + off) = pack8(g);
        }
    }
}

#define XB_TMO      128
#define XB_XCNT(j)  (256  + 64 * (j))
#define XB_XSUB(j)  (1280 + 64 * (j))
#define XB_XGEN(j)  (2304 + 64 * (j))
#define XB_TOP      3328
#define XB_TOPGEN   3392
#define XCD_BAR_WORDS 3456
#define XB_SPIN_CAP (1u << 18)

__device__ __forceinline__ unsigned xb_ld(unsigned* p)              { return __hip_atomic_load(p, __ATOMIC_RELAXED, __HIP_MEMORY_SCOPE_AGENT); }
__device__ __forceinline__ unsigned xb_add(unsigned* p, unsigned v) { return __hip_atomic_fetch_add(p, v, __ATOMIC_RELAXED, __HIP_MEMORY_SCOPE_AGENT); }
__device__ __forceinline__ unsigned xb_xcc_id() { return (unsigned)__builtin_amdgcn_s_getreg((3 << 11) | 20) & 0xFu; }
#define XB_SPIN(cond, bar) do { unsigned _sp = 0; while (cond) { __builtin_amdgcn_s_sleep(1); \
    if ((++_sp & 255u) == 0u) { if (xb_ld(&(bar)[XB_TMO])) break; if (_sp > XB_SPIN_CAP) { atomicAdd(&(bar)[XB_TMO], 1u); break; } } } } while (0)

struct XcdBarrier {
    unsigned* bar; unsigned x;
    volatile LAS unsigned* st;
};

__device__ __forceinline__ XcdBarrier xcd_barrier_post(unsigned* bar, volatile LAS unsigned* st) {
    XcdBarrier b; b.bar = bar; b.x = xb_xcc_id(); b.st = st;
    if (threadIdx.x == 0) (void)xb_add(&bar[XB_XCNT(b.x)], 1u);
    return b;
}
__device__ __forceinline__ void xcd_barrier_complete(unsigned* bar, unsigned x, unsigned& nloc, unsigned& nx) {
    const unsigned G = gridDim.x * gridDim.y * gridDim.z;
    unsigned sum, cnt, mine, sp = 0u;
    for (;;) {
        sum = 0u; cnt = 0u; mine = 0u;
#pragma unroll
        for (unsigned j = 0; j < 16; ++j) { const unsigned c = xb_ld(&bar[XB_XCNT(j)]); sum += c; cnt += (c > 0u) ? 1u : 0u; mine = (j == x) ? c : mine; }
        if (sum == G) break;
        __builtin_amdgcn_s_sleep(1);
        if ((++sp & 255u) == 0u) { if (xb_ld(&bar[XB_TMO])) break; if (sp > XB_SPIN_CAP) { atomicAdd(&bar[XB_TMO], 1u); break; } }
    }
    nloc = mine > 0u ? mine : 1u; nx = cnt > 0u ? cnt : 1u;
}

__device__ __forceinline__ void xcd_barrier(const XcdBarrier& b) {
    asm volatile("s_waitcnt vmcnt(0)" ::: "memory");
    __syncthreads();
    if (threadIdx.x == 0) {
        unsigned* bar = b.bar;
        __builtin_amdgcn_s_waitcnt(0);
        unsigned nloc = b.st[0], nx = b.st[1];
        if (nloc == 0u) { xcd_barrier_complete(bar, b.x, nloc, nx); b.st[0] = nloc; b.st[1] = nx; }
        const unsigned old = xb_add(&bar[XB_XSUB(b.x)], 1u);
        const unsigned gen = old / nloc;
        if (old + 1u == (gen + 1u) * nloc) {
            __builtin_amdgcn_fence(__ATOMIC_RELEASE, "agent");
            asm volatile("s_waitcnt vmcnt(0)" ::: "memory");
            const unsigned og = xb_add(&bar[XB_TOP], 1u);
            const unsigned tg = og / nx;
            if (og + 1u == (tg + 1u) * nx) xb_add(&bar[XB_TOPGEN], 1u);
            else XB_SPIN(xb_ld(&bar[XB_TOPGEN]) == tg, bar);
            __builtin_amdgcn_fence(__ATOMIC_ACQUIRE, "agent");
            xb_add(&bar[XB_XGEN(b.x)], 1u);
            asm volatile("s_waitcnt vmcnt(0)" ::: "memory");
        } else {
            XB_SPIN(xb_ld(&bar[XB_XGEN(b.x)]) == gen, bar);
            __builtin_amdgcn_fence(__ATOMIC_ACQUIRE, "agent");
            asm volatile("s_waitcnt vmcnt(0)" ::: "memory");
        }
    }
    __syncthreads();
}

struct Args { const float* in[23]; float* out; unsigned char* ws; int ph_lo, ph_hi; };
static_assert(sizeof(Args) == 23 * 8 + 8 + 8 + 8, "Args has no padding");

template <class Epi> __device__ __forceinline__ void run_gemm(LAS unsigned char* lds, const bf16* A, const bf16* Bt, int N, int K, const Epi& E) {
    pg8::Gemm g{A, Bt, M, N, K, K}; pg8::StaticOrder S; S.init(M, N, (int)gridDim.x, (int)blockIdx.x);
    pg8::gemm_phase<Epi, pg8::StaticOrder, true, true>(lds, g, S, E);
}
__device__ __forceinline__ void run_gemm_res(LAS unsigned char* lds, const bf16* A, const bf16* Bt, int K, const EpiRes& E, float* PART, int KS) {
    { pg8::Gemm g{A, Bt, MP, D, K, K}; pg8::StaticOrder S; S.init(MP, D, (int)gridDim.x, (int)blockIdx.x);
      pg8::gemm_phase<EpiRes, pg8::StaticOrder, true, true>(lds, g, S, E); }
    { const int KL = K / KS; pg8::Gemm g{A, Bt, M, D, K, KL}; SplitOrder S{D / 256, KS, KL, (int)gridDim.x, (int)blockIdx.x}; EpiPartial EP{PART, KL};
      pg8::gemm_phase<EpiPartial, SplitOrder, true, true>(lds, g, S, EP); }
}

__global__ void __launch_bounds__(512, 2) mega_fwd(Args a) {
    extern __shared__ __attribute__((aligned(16))) unsigned char lds_raw[];
    LAS unsigned char* lds = (LAS unsigned char*)lds_raw;
    cg::grid_group grid = cg::this_grid();
    unsigned char* ws = a.ws; float* out = a.out;
    const int lo = a.ph_lo, hi = a.ph_hi;
#define IN(k) (lo <= (k) && (k) < hi)
#ifndef DUP_PHASE
#define DUP_PHASE -1
#endif
#define SEAM(k) do { if (IN(k) && IN((k) + 1)) { if ((k) == 0) { asm volatile("s_waitcnt vmcnt(0) lgkmcnt(0)" ::: "memory"); grid.sync(); } else xcd_barrier(xbar); } } while (0)
    volatile LAS unsigned* xst = (volatile LAS unsigned*)(lds + LDS_BYTES);
    if (threadIdx.x < 2) xst[threadIdx.x] = 0u;
    __syncthreads();
    XcdBarrier xbar = xcd_barrier_post((unsigned*)(ws + WS_BAR), xst);
    float* mods = (float*)(ws + WS_MODS);
    bf16* H = (bf16*)(ws + WS_H);
    unsigned char* wb = ws + WS_W; unsigned char* R = ws + WS_R;
    float* X = out + OUT_Y;
    float* PART = (float*)(R + R_O);
    constexpr int KS2 = 8, KS4 = 8, KS5 = 11;

    if (IN(0)) ph_prologue(a.in, ws, lds);
#if DUP_PHASE == 0
    __syncthreads();
    if (IN(0)) ph_prologue(a.in, ws, lds);
#endif
    SEAM(0);
    if (IN(1)) ph_norm(a.in[0], a.in[1], a.in[8], mods + 0 * D, mods + 1 * D, H, nullptr, 0, nullptr, nullptr);
#if DUP_PHASE == 1
    __syncthreads();
    if (IN(1)) ph_norm(a.in[0], a.in[1], a.in[8], mods + 0 * D, mods + 1 * D, H, nullptr, 0, nullptr, nullptr);
#endif
    SEAM(1);
    if (IN(2)) { EpiInAB E{(bf16*)(R + R_U), (bf16*)(R + R_V), (bf16*)(R + R_XB), out + OUT_POOLP, out + OUT_POOLS};
        run_gemm(lds, H, (const bf16*)(wb + W0_IN), 3072, D, E); }
#if DUP_PHASE == 2
    __syncthreads();
    if (IN(2)) { EpiInAB E{(bf16*)(R + R_U), (bf16*)(R + R_V), (bf16*)(R + R_XB), out + OUT_POOLP, out + OUT_POOLS};
        run_gemm(lds, H, (const bf16*)(wb + W0_IN), 3072, D, E); }
#endif
    SEAM(2);
    if (IN(3)) ph_mixer(a.in, ws, out, lds);
#if DUP_PHASE == 3
    __syncthreads();
    if (IN(3)) ph_mixer(a.in, ws, out, lds);
#endif
    SEAM(3);
    if (IN(4)) { EpiRes E{a.in[0], a.in[1], X, mods + 2 * D}; run_gemm_res(lds, H, (const bf16*)(wb + W0_OUT), D, E, PART, KS2); }
    SEAM(4);
    if (IN(5)) ph_norm(X, a.in[1], a.in[9], mods + 3 * D, mods + 4 * D, H, PART, KS2, mods + 2 * D, X);
    SEAM(5);
    if (IN(6)) { EpiSwiGLU E{(bf16*)(R + R_ACT)}; run_gemm(lds, H, (const bf16*)(wb + W0_GU), 2 * DFF, D, E); }
#if DUP_PHASE == 6
    __syncthreads();
    if (IN(6)) { EpiSwiGLU E{(bf16*)(R + R_ACT)}; run_gemm(lds, H, (const bf16*)(wb + W0_GU), 2 * DFF, D, E); }
#endif
    SEAM(6);
    if (IN(7)) { EpiRes E{X, X + (size_t)MP * D, X, mods + 5 * D}; run_gemm_res(lds, (const bf16*)(R + R_ACT), (const bf16*)(wb + W0_DN), DFF, E, PART, KS5); }
    SEAM(7);
    if (IN(8)) {
        ph_norm(X, X + (size_t)MP * D, a.in[8] + D, mods + (size_t)NBI * NMOD + 0 * D, mods + (size_t)NBI * NMOD + 1 * D, H, PART, KS5, mods + 5 * D, X);
        __syncthreads();
        const int lane = threadIdx.x & 63, wave = threadIdx.x >> 6; LAS float* scr = (LAS float*)(lds + wave * 16384);
        const int gw = blockIdx.x * 8 + wave, ngw = gridDim.x * 8;
        convert_weight(a.in[19], D, NQKVG, (bf16*)(wb + W1_IN), 0, scr, lane, gw, ngw);
        convert_weight(a.in[20], VW, D, (bf16*)(wb + W1_OUT), 0, scr, lane, gw, ngw);
        convert_weight(a.in[21] + (size_t)D * 2 * DFF, D, 2 * DFF, (bf16*)(wb + W1_GU), 1, scr, lane, gw, ngw);
        convert_weight(a.in[22] + (size_t)DFF * D, DFF, D, (bf16*)(wb + W1_DN), 0, scr, lane, gw, ngw);
    }
    SEAM(8);
    if (IN(9)) { EpiQKVG E{(bf16*)(R + R_Q), (bf16*)(R + R_K), (bf16*)(R + R_VV), (bf16*)(R + R_G), (const float*)(ws + WS_COS), (const float*)(ws + WS_SIN)};
        run_gemm(lds, H, (const bf16*)(wb + W1_IN), NQKVG, D, E); }
#if DUP_PHASE == 9
    __syncthreads();
    if (IN(9)) { EpiQKVG E{(bf16*)(R + R_Q), (bf16*)(R + R_K), (bf16*)(R + R_VV), (bf16*)(R + R_G), (const float*)(ws + WS_COS), (const float*)(ws + WS_SIN)};
        run_gemm(lds, H, (const bf16*)(wb + W1_IN), NQKVG, D, E); }
#endif
    SEAM(9);
    if (IN(10)) ph_scores(ws);
#if DUP_PHASE == 10
    __syncthreads();
    if (IN(10)) ph_scores(ws);
#endif
    SEAM(10);
    if (IN(11)) ph_retention(a.in, ws, out, lds);
#if DUP_PHASE == 11
    __syncthreads();
    if (IN(11)) ph_retention(a.in, ws, out, lds);
#endif
    SEAM(11);
    if (IN(12)) ph_gate_norm(ws);
    SEAM(12);
    if (IN(13)) { EpiRes E{X, X + (size_t)MP * D, X, mods + (size_t)NBI * NMOD + 2 * D}; run_gemm_res(lds, (const bf16*)(R + R_G), (const bf16*)(wb + W1_OUT), VW, E, PART, KS4); }
    SEAM(13);
    if (IN(14)) ph_norm(X, X + (size_t)MP * D, a.in[9] + D, mods + (size_t)NBI * NMOD + 3 * D, mods + (size_t)NBI * NMOD + 4 * D, H, PART, KS4, mods + (size_t)NBI * NMOD + 2 * D, X);
    SEAM(14);
    if (IN(15)) { EpiSwiGLU E{(bf16*)(R + R_ACT)}; run_gemm(lds, H, (const bf16*)(wb + W1_GU), 2 * DFF, D, E); }
    SEAM(15);
    if (IN(16)) { EpiRes E{X, X + (size_t)MP * D, X, mods + (size_t)NBI * NMOD + 5 * D}; run_gemm_res(lds, (const bf16*)(R + R_ACT), (const bf16*)(wb + W1_DN), DFF, E, PART, KS5); }
    SEAM(16);
    if (IN(17)) ph_final_norm(X, a.in[10], PART, KS5, mods + (size_t)NBI * NMOD + 5 * D);
#undef IN
#undef SEAM
}

#ifndef N_PHASES_RUN
#define N_PHASES_RUN 18
#endif
extern "C" void kernel_launch(void* const* d_in, const int* in_sizes, int n_in, void* d_out, int out_size, void* d_ws, size_t ws_size, hipStream_t stream) {
    static int grid = 0;
    if (grid == 0) {
        if (n_in != 23 || ws_size < WS_END) { fprintf(stderr, "kernel_launch: unexpected n_in %d / ws_size %zu (need %zu)\n", n_in, ws_size, (size_t)WS_END); grid = -1; return; }
        int dev = 0, cus = 0, per_cu = 0;
        hipGetDevice(&dev); hipDeviceGetAttribute(&cus, hipDeviceAttributeMultiprocessorCount, dev);
        if (hipFuncSetAttribute((const void*)mega_fwd, hipFuncAttributeMaxDynamicSharedMemorySize, LDS_BYTES + 256) != hipSuccess) { fprintf(stderr, "kernel_launch: hipFuncSetAttribute failed\n"); grid = -1; return; }
        if (hipOccupancyMaxActiveBlocksPerMultiprocessor(&per_cu, (const void*)mega_fwd, 512, LDS_BYTES + 256) != hipSuccess || per_cu < 1) per_cu = 1;
        (void)hipGetLastError();
        grid = cus * per_cu;
    }
    if (grid < 0) return;
    Args a{};
    for (int i = 0; i < 23; ++i) a.in[i] = (const float*)d_in[i];
    a.out = (float*)d_out; a.ws = (unsigned char*)d_ws; a.ph_lo = 0; a.ph_hi = N_PHASES_RUN;
    if (hipMemsetAsync((char*)d_ws + WS_BAR, 0, XCD_BAR_WORDS * 4, stream) != hipSuccess) { fprintf(stderr, "kernel_launch: memset failed\n"); return; }
    void* args[] = {&a};
    hipError_t e = hipLaunchCooperativeKernel((const void*)mega_fwd, dim3(grid), dim3(512), args, LDS_BYTES + 256, stream);
    if (e != hipSuccess) fprintf(stderr, "kernel_launch: cooperative launch failed: %s (grid %d)\n", hipGetErrorString(e), grid);
}
```

```cpp
#include <hip/hip_runtime.h>
#include <hip/hip_cooperative_groups.h>
#include <cstdio>
#include <cstdint>
namespace cg = cooperative_groups;
namespace pg8 {
#define PG8_LAS __attribute__((address_space(3)))
typedef unsigned short bf16_t;
typedef short bf16x8 __attribute__((ext_vector_type(8)));
typedef float f32x4 __attribute__((ext_vector_type(4)));
typedef unsigned u32x4 __attribute__((ext_vector_type(4)));
constexpr int BM = 256, BK = 64, HALF = 128, HTB = HALF * BK * 2  , STAGE_BYTES = 8 * HTB, NXCD = 8, WGM = 8;

__host__ __device__ __forceinline__ int lds_byte(int r, int c) { const int st = (r >> 4) * 2 + (c >> 5), rr = r & 15, cc = c & 31, ob = rr * 64 + cc * 2; return st * 1024 + (ob ^ (((ob >> 9) & 1) << 5)); }
__host__ __device__ __forceinline__ void stage_rc(int b, int& R, int& C) { const int st = b / 1024, sb = b % 1024, swz = sb ^ (((sb >> 9) & 1) << 5); R = (st >> 1) * 16 + swz / 64; C = (st & 1) * 32 + (swz % 64) / 2; }
__host__ __device__ __forceinline__ int perm32(int rho) { const int n = rho >> 4, i = rho & 15; return 8 * (i >> 2) + 4 * n + (i & 3); }

struct Unit { int pm, pn, k0; };
struct Gemm { const bf16_t* A; const bf16_t* Bt; int M, N, K, KL; };

struct StaticOrder {
    int nM, nN, nwg, G, c;
    __host__ __device__ void init(int M, int N, int G_, int c_) { nM = M / BM; nN = N / BM; nwg = nM * nN; G = G_; c = c_; }
    __host__ __device__ bool next(int i, Unit& u) const {
        const long L = (long)i * G + c; if (L >= nwg) return false;
        int wgid = (int)L; { const int q = nwg / NXCD, r = nwg % NXCD, xcd = wgid % NXCD, off = wgid / NXCD; wgid = (xcd < r ? xcd * (q + 1) : r * (q + 1) + (xcd - r) * q) + off; }
        const int nig = WGM * nN, gid = wgid / nig, fm = gid * WGM, gsz = (nM - fm) < WGM ? (nM - fm) : WGM;
        u.pm = fm + ((wgid % nig) % gsz); u.pn = (wgid % nig) / gsz; u.k0 = 0; return true;
    }
    __device__ __forceinline__ void a_ready(const Unit&) const {}
    __device__ __forceinline__ void done(const Unit&) const {}
};

__device__ __forceinline__ unsigned cvt_pk_bf16(float lo, float hi) { unsigned r; asm volatile("v_cvt_pk_bf16_f32 %0, %1, %2" : "=v"(r) : "v"(lo), "v"(hi)); return r; }
typedef float f32x2 __attribute__((ext_vector_type(2)));
template <class Epi, class Sched, bool ALIGN_EPI = false, bool SP2 = false>
__device__ __forceinline__ void gemm_phase(PG8_LAS unsigned char* lds, const Gemm g, const Sched& S, const Epi& E) {
    const int tid = threadIdx.x, wid = __builtin_amdgcn_readfirstlane(tid >> 6), lane = tid & 63, wr = wid >> 2, wc = wid & 3, fr = lane & 15, fq = lane >> 4;
    const int K = g.K, nt = g.KL / BK;
    unsigned voffA[2], voffB[2];
#pragma unroll
    for (int i = 0; i < 2; ++i) { int R, C; stage_rc(tid * 16 + i * 8192, R, C); const int Rb = Epi::PERM ? ((R & ~31) + perm32(R & 31)) : R;
        voffA[i] = (unsigned)(R * K + C) * 2u; voffB[i] = (unsigned)(Rb * K + C) * 2u; }
    const size_t kstep = (size_t)(BK * 2);
    const size_t hstep = (size_t)HALF * K * 2;
    const size_t tstep = 2 * hstep;
    const unsigned ldsw = (unsigned)wid * 1024u;
    const int aoff = lds_byte(wr * 64 + fr, fq * 8), boff = lds_byte(wc * 32 + fr, fq * 8);
#define PG8_SA(b, h) (((b) * 2 + (h)) * HTB)
#define PG8_SB(b, h) ((4 + (b) * 2 + (h)) * HTB)
#define PG8_STAGE(bufoff, gbase, voff) do { _Pragma("unroll") for (int _i = 0; _i < 2; ++_i) \
        __builtin_amdgcn_global_load_lds((const unsigned*)((const char*)(gbase) + (voff)[_i]), (PG8_LAS unsigned*)(lds + (bufoff) + ldsw + _i * 8192), 16, 0, 0); } while (0)
#define PG8_LDA(dst, b, h) do { _Pragma("unroll") for (int m = 0; m < 4; ++m) _Pragma("unroll") for (int k = 0; k < 2; ++k) dst[m][k] = *(const PG8_LAS bf16x8*)(lds + PG8_SA(b, h) + aoff + m * 2048 + k * 1024); } while (0)
#define PG8_LDB(dst, b, h) do { _Pragma("unroll") for (int n = 0; n < 2; ++n) _Pragma("unroll") for (int k = 0; k < 2; ++k) dst[n][k] = *(const PG8_LAS bf16x8*)(lds + PG8_SB(b, h) + boff + n * 2048 + k * 1024); } while (0)
#define PG8_MMA(ai, bj, At, Bt) do { __builtin_amdgcn_s_setprio(1); _Pragma("unroll") for (int m = 0; m < 4; ++m) _Pragma("unroll") for (int n = 0; n < 2; ++n) _Pragma("unroll") for (int k = 0; k < 2; ++k) \
        acc[ai][bj][m][n] = __builtin_amdgcn_mfma_f32_16x16x32_bf16(Bt[n][k], At[m][k], acc[ai][bj][m][n], 0, 0, 0); __builtin_amdgcn_s_setprio(0); } while (0)
#define PG8_WAIT_V(n) asm volatile("s_waitcnt vmcnt(" #n ")" ::: "memory")
#define PG8_WAIT_L(n) asm volatile("s_waitcnt lgkmcnt(" #n ")" ::: "memory")
#define PG8_BAR __builtin_amdgcn_s_barrier()
#define PG8_SCHED __builtin_amdgcn_sched_barrier(0)
    Unit cur, nxt; int ui = 0;
    if (!S.next(0, cur)) return;
    f32x4 acc[2][2][4][2];
#pragma unroll
    for (int a = 0; a < 2; ++a)
#pragma unroll
        for (int b = 0; b < 2; ++b)
#pragma unroll
            for (int m = 0; m < 4; ++m)
#pragma unroll
                for (int n = 0; n < 2; ++n) acc[a][b][m][n] = (f32x4){0.f, 0.f, 0.f, 0.f};
    bf16x8 At[4][2], B0[2][2], B1[2][2];
    const char* cA = (const char*)g.A + (size_t)cur.pm * tstep + (size_t)cur.k0 * 2; const char* cB = (const char*)g.Bt + (size_t)cur.pn * tstep + (size_t)cur.k0 * 2;
    S.a_ready(cur);
    if constexpr (SP2) {
        PG8_STAGE(PG8_SB(0, 0), cB, voffB); PG8_STAGE(PG8_SB(0, 1), cB + hstep, voffB); PG8_STAGE(PG8_SA(0, 0), cA, voffA); PG8_STAGE(PG8_SA(0, 1), cA + hstep, voffA);
        if (wr == 1) PG8_BAR;
        PG8_WAIT_V(2); PG8_BAR;
        PG8_STAGE(PG8_SB(1, 0), cB + kstep, voffB); PG8_STAGE(PG8_SA(1, 0), cA + kstep, voffA); PG8_STAGE(PG8_SB(1, 1), cB + hstep + kstep, voffB);
        PG8_WAIT_V(6); PG8_BAR;
    } else {
        PG8_STAGE(PG8_SB(0, 0), cB, voffB); PG8_STAGE(PG8_SA(0, 0), cA, voffA); PG8_STAGE(PG8_SB(0, 1), cB + hstep, voffB); PG8_STAGE(PG8_SA(0, 1), cA + hstep, voffA);
        if (wr == 1) PG8_BAR;
        PG8_WAIT_V(4); PG8_BAR;
        PG8_STAGE(PG8_SB(1, 0), cB + kstep, voffB); PG8_STAGE(PG8_SA(1, 0), cA + kstep, voffA); PG8_STAGE(PG8_SB(1, 1), cB + hstep + kstep, voffB);
        PG8_WAIT_V(6); PG8_BAR;
    }
    for (;;) {
        const bool has_next = S.next(ui + 1, nxt);
        const char* nA = has_next ? (const char*)g.A + (size_t)nxt.pm * tstep + (size_t)nxt.k0 * 2 : cA; const char* nB = has_next ? (const char*)g.Bt + (size_t)nxt.pn * tstep + (size_t)nxt.k0 * 2 : cB;
        for (int t = 0; t < nt; t += 2) {
            const bool last = (t == nt - 2);
            const char* a1 = cA + (size_t)(t + 1) * kstep;
            const char* a2 = last ? nA : cA + (size_t)(t + 2) * kstep; const char* b2 = last ? nB : cB + (size_t)(t + 2) * kstep;
            const char* a3 = a2 + kstep; const char* b3 = b2 + kstep;
            if (last && has_next) S.a_ready(nxt);
            if constexpr (SP2) {
            PG8_LDB(B0, 0, 0); PG8_LDB(B1, 0, 1); PG8_SCHED; PG8_LDA(At, 0, 0); PG8_STAGE(PG8_SA(1, 1), a1 + hstep, voffA);
            PG8_WAIT_V(8); PG8_WAIT_L(0); PG8_BAR; PG8_MMA(0, 0, At, B0); PG8_MMA(0, 1, At, B1); PG8_BAR; PG8_SCHED;
            PG8_LDA(At, 0, 1); PG8_STAGE(PG8_SB(0, 0), b2, voffB); PG8_STAGE(PG8_SB(0, 1), b2 + hstep, voffB); PG8_STAGE(PG8_SA(0, 0), a2, voffA);
            PG8_WAIT_V(8); PG8_WAIT_L(0); PG8_BAR; PG8_MMA(1, 0, At, B0); PG8_MMA(1, 1, At, B1); PG8_BAR; PG8_SCHED;
            PG8_LDB(B0, 1, 0); PG8_LDB(B1, 1, 1); PG8_SCHED; PG8_LDA(At, 1, 0); PG8_STAGE(PG8_SA(0, 1), a2 + hstep, voffA);
            PG8_WAIT_V(8); PG8_WAIT_L(0); PG8_BAR; PG8_MMA(0, 0, At, B0); PG8_MMA(0, 1, At, B1); PG8_BAR; PG8_SCHED;
            PG8_LDA(At, 1, 1); PG8_STAGE(PG8_SB(1, 0), b3, voffB); PG8_STAGE(PG8_SB(1, 1), b3 + hstep, voffB); PG8_STAGE(PG8_SA(1, 0), a3, voffA);
            PG8_WAIT_V(8); PG8_WAIT_L(0); PG8_BAR; PG8_MMA(1, 0, At, B0); PG8_MMA(1, 1, At, B1); PG8_BAR; PG8_SCHED;
            } else {
            PG8_LDB(B0, 0, 0); PG8_SCHED; PG8_LDA(At, 0, 0); PG8_STAGE(PG8_SA(1, 1), a1 + hstep, voffA);
            PG8_WAIT_L(8); PG8_BAR; PG8_WAIT_L(0); PG8_MMA(0, 0, At, B0); PG8_BAR; PG8_SCHED;
            PG8_LDB(B1, 0, 1); PG8_STAGE(PG8_SB(0, 0), b2, voffB);
            PG8_BAR; PG8_WAIT_L(0); PG8_MMA(0, 1, At, B1); PG8_BAR;
            PG8_LDA(At, 0, 1); PG8_STAGE(PG8_SA(0, 0), a2, voffA);
            PG8_BAR; PG8_WAIT_L(0); PG8_MMA(1, 0, At, B0); PG8_BAR; PG8_SCHED;
            PG8_STAGE(PG8_SB(0, 1), b2 + hstep, voffB);
            PG8_WAIT_V(6); PG8_BAR; PG8_MMA(1, 1, At, B1); PG8_BAR;
            PG8_LDB(B0, 1, 0); PG8_SCHED; PG8_LDA(At, 1, 0); PG8_STAGE(PG8_SA(0, 1), a2 + hstep, voffA);
            PG8_WAIT_L(8); PG8_BAR; PG8_WAIT_L(0); PG8_MMA(0, 0, At, B0); PG8_BAR; PG8_SCHED;
            PG8_LDB(B1, 1, 1); PG8_STAGE(PG8_SB(1, 0), b3, voffB);
            PG8_BAR; PG8_WAIT_L(0); PG8_MMA(0, 1, At, B1); PG8_BAR;
            PG8_LDA(At, 1, 1); PG8_STAGE(PG8_SA(1, 0), a3, voffA);
            PG8_BAR; PG8_WAIT_L(0); PG8_MMA(1, 0, At, B0); PG8_BAR; PG8_SCHED;
            PG8_STAGE(PG8_SB(1, 1), b3 + hstep, voffB);
            PG8_WAIT_V(6); PG8_BAR; PG8_MMA(1, 1, At, B1); PG8_BAR;
            }
        }
        if constexpr (ALIGN_EPI) { if (wr == 0) PG8_BAR; }
        if constexpr (!Epi::AFTER_DRAIN) { E(acc, cur, wr, wc, fr, fq); S.done(cur); }
        if (!has_next) break;
#pragma unroll
        for (int a = 0; a < 2; ++a)
#pragma unroll
            for (int b = 0; b < 2; ++b)
#pragma unroll
                for (int m = 0; m < 4; ++m)
#pragma unroll
                    for (int n = 0; n < 2; ++n) acc[a][b][m][n] = (f32x4){0.f, 0.f, 0.f, 0.f};
        cur = nxt; cA = nA; cB = nB; ++ui;
        if constexpr (ALIGN_EPI) { if (wr == 1) PG8_BAR; }
    }
    PG8_WAIT_V(0);
    if constexpr (!ALIGN_EPI) { if (wr == 0) PG8_BAR; }
    PG8_BAR;
    if constexpr (Epi::AFTER_DRAIN) { E.fused(acc, cur, wr, wc, fr, fq, lds, wid, lane); S.done(cur); }
#undef PG8_SA
#undef PG8_SB
#undef PG8_STAGE
#undef PG8_LDA
#undef PG8_LDB
#undef PG8_MMA
#undef PG8_WAIT_V
#undef PG8_WAIT_L
#undef PG8_BAR
#undef PG8_SCHED
}
}
#define LAS __attribute__((address_space(3)))
typedef unsigned short bf16;
typedef float f32x4 __attribute__((ext_vector_type(4)));
typedef float f32x2 __attribute__((ext_vector_type(2)));
typedef unsigned u32x4 __attribute__((ext_vector_type(4)));
typedef unsigned u32x2 __attribute__((ext_vector_type(2)));
typedef short bf16x8 __attribute__((ext_vector_type(8)));
typedef short s16x4 __attribute__((ext_vector_type(4)));

constexpr int D = 2048, SEQ = 8192, MP = 16384, MS = 512, M = MP + MS, NBI = 18;
constexpr int AW = 1024, DFF = 5632, NQKVG = 12288, VW = 4096, NMOD = 12288;
constexpr float EPS = 1e-6f;
constexpr int LDS_BYTES = 147456;

constexpr size_t OUT_Y = 0, OUT_POOLP = 34603008, OUT_POOLS = 34633728, OUT_VS = 34879488, OUT_RETP = 35403776, OUT_RETS = 37500928;
constexpr size_t WS_BAR = 0;
constexpr size_t WS_MODS = 65536;
constexpr size_t WS_COS = 3u << 20, WS_SIN = WS_COS + 4194304;
constexpr size_t WS_WSA = WS_SIN + 4194304;
constexpr size_t WS_WSB = WS_WSA + 262144;
constexpr size_t WS_WPT = WS_WSB + 262144;
constexpr size_t WS_PP = WS_WPT + 524288;
constexpr size_t WS_PS = WS_PP + 16777216;
constexpr size_t WS_W = 32u << 20;
constexpr size_t W0_IN = 0, W0_OUT = W0_IN + (size_t)3072 * 2048 * 2, W0_GU = W0_OUT + (size_t)2048 * 2048 * 2, W0_DN = W0_GU + (size_t)11264 * 2048 * 2;
constexpr size_t W1_IN = 0, W1_OUT = W1_IN + (size_t)12288 * 2048 * 2, W1_GU = W1_OUT + (size_t)2048 * 4096 * 2, W1_DN = W1_GU + (size_t)11264 * 2048 * 2;
constexpr size_t W_BYTES = W1_DN + (size_t)2048 * 5632 * 2;
constexpr size_t WS_H = WS_W + W_BYTES;
constexpr size_t WS_R = WS_H + (size_t)M * 2048 * 2;
constexpr size_t R_U = 0, R_V = R_U + (size_t)M * 1024 * 2, R_XB = R_V + (size_t)M * 1024 * 2;
constexpr size_t R_ACT = 0;
constexpr size_t R_Q = 0, R_K = R_Q + (size_t)M * 2048 * 2, R_VV = R_K + (size_t)M * 2048 * 2, R_G = R_VV + (size_t)M * 4096 * 2, R_O = R_G + (size_t)M * 4096 * 2;
constexpr size_t WS_END = WS_R + R_O + (size_t)M * 4096 * 2;
static_assert(WS_PS + 262144 <= WS_W, "ws map");
static_assert(WS_END <= 850000000ull, "ws too large");

__device__ __forceinline__ float bf2f(unsigned h) { return __uint_as_float(h << 16); }
typedef __bf16 bf16x2_t __attribute__((ext_vector_type(2)));
__device__ __forceinline__ unsigned pk2(float lo, float hi) { const f32x2 v = {lo, hi}; return __builtin_bit_cast(unsigned, __builtin_convertvector(v, bf16x2_t)); }
__device__ __forceinline__ float silu_f(float x) { return x * __builtin_amdgcn_rcpf(1.0f + __expf(-x)); }
__device__ __forceinline__ float gelu_tanh_f(float x) { const float z = 0.7978845608028654f * (x + 0.044715f * x * x * x); return x * __builtin_amdgcn_rcpf(1.0f + __expf(-2.0f * z)); }
__device__ __forceinline__ float wave_sum(float v) {
#pragma unroll
    for (int o = 1; o < 64; o <<= 1) v += __shfl_xor(v, o);
    return v;
}
__device__ __forceinline__ void unpack8(const u32x4 w, float (&f)[8]) {
    f[0] = __uint_as_float(w.x << 16); f[1] = __uint_as_float(w.x & 0xffff0000u); f[2] = __uint_as_float(w.y << 16); f[3] = __uint_as_float(w.y & 0xffff0000u);
    f[4] = __uint_as_float(w.z << 16); f[5] = __uint_as_float(w.z & 0xffff0000u); f[6] = __uint_as_float(w.w << 16); f[7] = __uint_as_float(w.w & 0xffff0000u);
}
__device__ __forceinline__ u32x4 pack8(const float (&f)[8]) { u32x4 w; w.x = pk2(f[0], f[1]); w.y = pk2(f[2], f[3]); w.z = pk2(f[4], f[5]); w.w = pk2(f[6], f[7]); return w; }
__device__ __forceinline__ int row_bi(int row) { return row < MP ? (row >> 13) : 2 + ((row - MP) >> 5); }
__device__ __forceinline__ float head_log_g(int h) { return log1pf(-exp2f(-5.0f - (float)h)); }
#define MFMA16(a, b, c) __builtin_amdgcn_mfma_f32_16x16x32_bf16((a), (b), (c), 0, 0, 0)
__device__ __forceinline__ int hm_row(int r, int h) { return r < MP ? (((r >> 13) * 8 + h) << 13) + (r & 8191) : MP * 8 + ((((r - MP) >> 5) * 8 + h) << 5) + ((r - MP) & 31); }
struct EpiInAB {
    static constexpr bool PERM = true, AFTER_DRAIN = false;
    bf16* U; bf16* V; bf16* XB; float* poolP; float* poolS;
    __device__ __forceinline__ void operator()(const f32x4 (&acc)[2][2][4][2], const pg8::Unit& u, int wr, int wc, int fr, int fq) const {
        const int t = u.pn >> 2, colt = (u.pn & 3) * 256 + wc * 32 + 8 * fq;
        bf16* base = U + (size_t)t * ((size_t)M * 1024);
#pragma unroll
        for (int ai = 0; ai < 2; ++ai)
#pragma unroll
            for (int m = 0; m < 4; ++m) {
                const int row = u.pm * 256 + ai * 128 + wr * 64 + m * 16 + fr;
                bf16* rowp = base + (size_t)row * 1024 + colt;
                float* sp = nullptr;
                if (t == 2) {
                    if (row < MP) { const int pos = row & 8191; if (pos >= 8177) sp = poolP + ((size_t)(row >> 13) * 15 + (pos - 8177)) * 1024 + colt; }
                    else { const int i = (row - MP) & 31; if (i >= 17) sp = poolS + ((size_t)((row - MP) >> 5) * 15 + (i - 17)) * 1024 + colt; }
                }
#pragma unroll
                for (int bj = 0; bj < 2; ++bj) {
                    f32x4 v0 = acc[ai][bj][m][0], v1 = acc[ai][bj][m][1];
                    if (t < 2) {
#pragma unroll
                        for (int j = 0; j < 4; ++j) { v0[j] = gelu_tanh_f(v0[j]); v1[j] = gelu_tanh_f(v1[j]); }
                    }
                    u32x4 w; w.x = pk2(v0[0], v0[1]); w.y = pk2(v0[2], v0[3]); w.z = pk2(v1[0], v1[1]); w.w = pk2(v1[2], v1[3]);
                    *(u32x4*)(rowp + bj * 128) = w;
                    if (sp) { *(f32x4*)(sp + bj * 128) = v0; *(f32x4*)(sp + bj * 128 + 4) = v1; }
                }
            }
    }
};
struct EpiRes {
    static constexpr bool PERM = false, AFTER_DRAIN = false;
    const float* baseP; const float* baseS; float* out; const float* gate;
    __device__ __forceinline__ void operator()(const f32x4 (&acc)[2][2][4][2], const pg8::Unit& u, int wr, int wc, int fr, int fq) const {
        const int col0 = u.pn * 256 + wc * 32 + 4 * fq;
#pragma unroll
        for (int ai = 0; ai < 2; ++ai)
#pragma unroll
            for (int m = 0; m < 4; ++m) {
                const int row = u.pm * 256 + ai * 128 + wr * 64 + m * 16 + fr;
                const float* bp = row < MP ? baseP + (size_t)row * D : baseS + (size_t)(row - MP) * D;
                const float* gp = gate + (size_t)row_bi(row) * NMOD;
                float* op = out + (size_t)row * D;
#pragma unroll
                for (int bj = 0; bj < 2; ++bj)
#pragma unroll
                    for (int n = 0; n < 2; ++n) { const int c = col0 + bj * 128 + n * 16;
                        const f32x4 b = *(const f32x4*)(bp + c), g = *(const f32x4*)(gp + c);
                        *(f32x4*)(op + c) = b + g * acc[ai][bj][m][n]; }
                if (m & 1) asm volatile("" ::: "memory");
            }
    }
};
struct EpiSwiGLU {
    static constexpr bool PERM = true, AFTER_DRAIN = false;
    bf16* ACT;
    __device__ __forceinline__ void operator()(const f32x4 (&acc)[2][2][4][2], const pg8::Unit& u, int wr, int wc, int fr, int fq) const {
        const int col0 = u.pn * 128 + wc * 32 + 8 * fq;
#pragma unroll
        for (int ai = 0; ai < 2; ++ai)
#pragma unroll
            for (int m = 0; m < 4; ++m) {
                const int row = u.pm * 256 + ai * 128 + wr * 64 + m * 16 + fr;
                float o[8];
#pragma unroll
                for (int n = 0; n < 2; ++n)
#pragma unroll
                    for (int j = 0; j < 4; ++j) o[n * 4 + j] = silu_f(acc[ai][0][m][n][j]) * acc[ai][1][m][n][j];
                *(u32x4*)(ACT + (size_t)row * DFF + col0) = pack8(o);
            }
    }
};
struct EpiQKVG {
    static constexpr bool PERM = true, AFTER_DRAIN = false;
    bf16* Q; bf16* K; bf16* V; bf16* G; const float* COS; const float* SIN;
    __device__ __forceinline__ void operator()(const f32x4 (&acc)[2][2][4][2], const pg8::Unit& u, int wr, int wc, int fr, int fq) const {
        const int pn = u.pn;
        if (pn < 16) {
            const int h = pn & 7; const bool isk = pn >= 8; const float lg = head_log_g(h) * 1.4426950408889634f;
            bf16* base = Q + (isk ? (size_t)M * 2048 : (size_t)0) + wc * 32 + 8 * fq;
            const int ch = wc * 32 + 8 * fq;
#pragma unroll
            for (int ai = 0; ai < 2; ++ai)
#pragma unroll
                for (int m = 0; m < 4; ++m) {
                    const int row = u.pm * 256 + ai * 128 + wr * 64 + m * 16 + fr;
                    int pos, n, L;
                    if (row < MP) { pos = row & 8191; n = pos & 63; L = 64; } else { n = (row - MP) & 31; pos = 2048 + n; L = 32; }
                    const float sc = isk ? 0.0625f * exp2f(lg * (float)(L - 1 - n)) : exp2f(lg * (float)(n + 1));
                    const f32x4 c0 = *(const f32x4*)(COS + (size_t)pos * 128 + ch), c1 = *(const f32x4*)(COS + (size_t)pos * 128 + ch + 4);
                    const f32x4 s0 = *(const f32x4*)(SIN + (size_t)pos * 128 + ch), s1 = *(const f32x4*)(SIN + (size_t)pos * 128 + ch + 4);
                    float o1[8], o2[8];
#pragma unroll
                    for (int j = 0; j < 4; ++j) {
                        const float a0 = acc[ai][0][m][0][j], b0 = acc[ai][1][m][0][j], a1 = acc[ai][0][m][1][j], b1 = acc[ai][1][m][1][j];
                        o1[j] = (a0 * c0[j] - b0 * s0[j]) * sc; o2[j] = (a0 * s0[j] + b0 * c0[j]) * sc;
                        o1[4 + j] = (a1 * c1[j] - b1 * s1[j]) * sc; o2[4 + j] = (a1 * s1[j] + b1 * c1[j]) * sc;
                    }
                    const int hrow = hm_row(row, h);
                    if (isk) { const size_t hr = (size_t)hrow * 256; *(u32x4*)(base + hr) = pack8(o1); *(u32x4*)(base + hr + 128) = pack8(o2); }
                    else {
                        bf16* qt = Q + ((size_t)(hrow >> 4) * 8 + wc) * 512 + (fq * 16 + (hrow & 15)) * 8;
                        *(u32x4*)qt = pack8(o1); *(u32x4*)(qt + 4 * 512) = pack8(o2); }
                }
        } else {
            const bool isg = pn >= 32; const int hv = (pn - 16) >> 1;
            bf16* base = V + (isg ? (size_t)M * 4096 + (size_t)(pn - 32) * 256 : (size_t)((pn - 16) & 1) * 256) + wc * 32 + 8 * fq;
#pragma unroll
            for (int ai = 0; ai < 2; ++ai)
#pragma unroll
                for (int m = 0; m < 4; ++m) {
                    const int row = u.pm * 256 + ai * 128 + wr * 64 + m * 16 + fr;
#pragma unroll
                    for (int bj = 0; bj < 2; ++bj) {
                        float o[8];
#pragma unroll
                        for (int n = 0; n < 2; ++n)
#pragma unroll
                            for (int j = 0; j < 4; ++j) { const float x = acc[ai][bj][m][n][j]; o[n * 4 + j] = isg ? silu_f(x) : x; }
                        *(u32x4*)(base + (isg ? (size_t)row * VW : (size_t)hm_row(row, hv) * 512) + bj * 128) = pack8(o);
                    }
                }
        }
    }
};
struct SplitOrder {
    int nN, KS, KL, G, c;
    __device__ __forceinline__ bool next(int i, pg8::Unit& u) const { const int L = i * G + c; if (L >= 2 * nN * KS) return false; u.pm = 64 + (L & 1); const int r = L >> 1; u.pn = r % nN; u.k0 = (r / nN) * KL; return true; }
    __device__ __forceinline__ void a_ready(const pg8::Unit&) const {}
    __device__ __forceinline__ void done(const pg8::Unit&) const {}
};
struct EpiPartial {
    static constexpr bool PERM = false, AFTER_DRAIN = false;
    float* PART; int KL;
    __device__ __forceinline__ void operator()(const f32x4 (&acc)[2][2][4][2], const pg8::Unit& u, int wr, int wc, int fr, int fq) const {
        const int col0 = u.pn * 256 + wc * 32 + 4 * fq, ks = u.k0 / KL;
#pragma unroll
        for (int ai = 0; ai < 2; ++ai)
#pragma unroll
            for (int m = 0; m < 4; ++m) {
                const int r = (u.pm - 64) * 256 + ai * 128 + wr * 64 + m * 16 + fr;
                float* op = PART + ((size_t)ks * MS + r) * D;
#pragma unroll
                for (int bj = 0; bj < 2; ++bj)
#pragma unroll
                    for (int n = 0; n < 2; ++n) *(f32x4*)(op + col0 + bj * 128 + n * 16) = acc[ai][bj][m][n];
            }
    }
};
__device__ __forceinline__ void transpose_item(const float* W, int K, int N, bf16* WT, int k0, int n0, int drow0, LAS float* scr, int lane) {
    float wv[32];
#pragma unroll
    for (int i = 0; i < 32; ++i) { const int kk = 2 * i + (lane >> 5); wv[i] = W[(size_t)(k0 + kk) * N + n0 + (lane & 31)]; }
#pragma unroll
    for (int i = 0; i < 32; ++i) { const int kk = 2 * i + (lane >> 5); scr[kk * 33 + (lane & 31)] = wv[i]; }
    asm volatile("s_waitcnt lgkmcnt(0)" ::: "memory");
    const int c = lane & 7;
#pragma unroll
    for (int j = 0; j < 4; ++j) { const int n = (lane >> 3) + 8 * j; const LAS float* s = scr + (8 * c) * 33 + n;
        u32x4 o; o.x = pk2(s[0 * 33], s[1 * 33]); o.y = pk2(s[2 * 33], s[3 * 33]); o.z = pk2(s[4 * 33], s[5 * 33]); o.w = pk2(s[6 * 33], s[7 * 33]);
        *(u32x4*)(WT + (size_t)(drow0 + n) * K + k0 + 8 * c) = o; }
    asm volatile("s_waitcnt lgkmcnt(0)" ::: "memory");
}
__device__ __forceinline__ void convert_weight(const float* W, int K, int N, bf16* WT, int mode, LAS float* scr, int lane, int gw, int ngw) {
    const int nblk = N / 32, nitems = (K / 64) * nblk;
    for (int it = gw; it < nitems; it += ngw) {
        const int kb = it / nblk, nb = it % nblk, n0 = nb * 32;
        int drow0 = n0;
        if (mode == 1) { if (n0 < DFF) drow0 = (n0 >> 7) * 256 + (n0 & 127); else { const int j0 = n0 - DFF; drow0 = (j0 >> 7) * 256 + 128 + (j0 & 127); } }
        transpose_item(W, K, N, WT, kb * 64, n0, drow0, scr, lane);
    }
}

__device__ __forceinline__ void ph_prologue(const float* const* in, unsigned char* ws, LAS unsigned char* lds) {
    const int tid = threadIdx.x, lane = tid & 63, wave = tid >> 6, G = gridDim.x;
    const float* c_p = in[2]; const float* c_s = in[3]; const float* w_ada = in[6]; const float* b_ada = in[7];
    float* mods = (float*)(ws + WS_MODS);
    LAS float* sc = (LAS float*)lds;
    LAS float* red = (LAS float*)(lds + 73728);
    for (int it = blockIdx.x; it < 192; it += G) {
        const int l = it / 96, nb = it % 96;
        const float* W = w_ada + (size_t)l * D * NMOD;
        f32x4 acc[NBI];
#pragma unroll
        for (int b = 0; b < NBI; ++b) acc[b] = (f32x4){0.f, 0.f, 0.f, 0.f};
        const int hh = lane >> 5, c4 = lane & 31;
        for (int kh = 0; kh < 2; ++kh) {
            __syncthreads();
            for (int e = tid; e < NBI * 1024; e += 512) { const int bi = e >> 10, kk = e & 1023;
                const float cv = bi < 2 ? c_p[bi * D + kh * 1024 + kk] : c_s[(bi - 2) * D + kh * 1024 + kk]; sc[e] = cv / (1.0f + __expf(-cv)); }
            __syncthreads();
            const float* wp = W + (size_t)(kh * 1024 + wave * 128 + hh) * NMOD + nb * 128 + c4 * 4;
            for (int j0 = 0; j0 < 64; j0 += 16) {
                f32x4 wv[16];
#pragma unroll
                for (int j = 0; j < 16; ++j) wv[j] = __builtin_nontemporal_load((const f32x4*)(wp + (size_t)(2 * (j0 + j)) * NMOD));
#pragma unroll
                for (int j = 0; j < 16; ++j) { const int kk = wave * 128 + 2 * (j0 + j) + hh;
#pragma unroll
                    for (int b = 0; b < NBI; ++b) { const float s = sc[b * 1024 + kk]; acc[b] += s * wv[j]; } }
            }
        }
#pragma unroll
        for (int b = 0; b < NBI; ++b)
#pragma unroll
            for (int q = 0; q < 4; ++q) acc[b][q] += __shfl_xor(acc[b][q], 32);
        if (lane < 32) {
#pragma unroll
            for (int b = 0; b < NBI; ++b) *(LAS f32x4*)(red + (wave * NBI + b) * 128 + c4 * 4) = acc[b];
        }
        __syncthreads();
        for (int e = tid; e < NBI * 128; e += 512) { const int bi = e >> 7, cc = e & 127;
            float s = b_ada[l * NMOD + nb * 128 + cc];
#pragma unroll
            for (int w = 0; w < 8; ++w) s += red[(w * NBI + bi) * 128 + cc];
            mods[(size_t)(l * NBI + bi) * NMOD + nb * 128 + cc] = s; }
    }
    __syncthreads();
    {
        LAS float* scr = (LAS float*)(lds + wave * 16384);
        const int gw = blockIdx.x * 8 + wave, ngw = G * 8;
        unsigned char* wb = ws + WS_W;
        convert_weight(in[11], D, 3072, (bf16*)(wb + W0_IN), 0, scr, lane, gw, ngw);
        convert_weight(in[18], D, D, (bf16*)(wb + W0_OUT), 0, scr, lane, gw, ngw);
        convert_weight(in[21], D, 2 * DFF, (bf16*)(wb + W0_GU), 1, scr, lane, gw, ngw);
        convert_weight(in[22], DFF, D, (bf16*)(wb + W0_DN), 0, scr, lane, gw, ngw);
    }
    const int gt = blockIdx.x * 512 + tid, ngt = G * 512;
    { const float* w_s = in[14]; bf16* wsa = (bf16*)(ws + WS_WSA); bf16* wsb = (bf16*)(ws + WS_WSB);
      for (int e = gt; e < 8 * 128 * 128; e += ngt) { const int g = e >> 14, t = (e >> 7) & 127, s = e & 127;
          const float a = ((s >> 6) <= (t >> 6)) ? w_s[e] : 0.f;
          const float b = ((s >> 5) == (t >> 5)) ? w_s[(g * 128 + (t & 31)) * 128 + (s & 31)] : 0.f;
          wsa[e] = (bf16)(pk2(a, 0.f) & 0xffffu); wsb[e] = (bf16)(pk2(b, 0.f) & 0xffffu); } }
    { const float* w_pool = in[16]; bf16* wpt = (bf16*)(ws + WS_WPT);
      for (int e = gt; e < 4 * 256 * 256; e += ngt) { const int g = e >> 16, d = (e >> 8) & 255, c = e & 255;
          wpt[e] = (bf16)(pk2(w_pool[(g * 256 + c) * 256 + d], 0.f) & 0xffffu); } }
    { float* COS = (float*)(ws + WS_COS); float* SIN = (float*)(ws + WS_SIN);
      for (int e = gt; e < 8192 * 128; e += ngt) { const int pos = e >> 7, ch = e & 127;
          const float freq = powf(10000.0f, -(float)ch / 128.0f); const float ang = (float)pos * freq;
          COS[e] = cosf(ang); SIN[e] = sinf(ang); } }
}

__device__ __forceinline__ void ph_norm(const float* xP, const float* xS, const float* g, const float* shiftb, const float* scaleb, bf16* H,
                                        const float* part, int KS, const float* gate, float* Xout) {
    const int lane = threadIdx.x & 63, gw = blockIdx.x * 8 + (threadIdx.x >> 6), ngw = gridDim.x * 8;
    for (int row = gw; row < M; row += ngw) {
        const f32x4* xr = (const f32x4*)(row < MP ? xP + (size_t)row * D : xS + (size_t)(row - MP) * D) + lane;
        const int bi = row_bi(row);
        f32x4 v[8];
#pragma unroll
        for (int j = 0; j < 8; ++j) v[j] = xr[64 * j];
        if (part && row >= MP) {
            f32x4 sacc[8];
#pragma unroll
            for (int j = 0; j < 8; ++j) sacc[j] = (f32x4){0.f, 0.f, 0.f, 0.f};
            for (int ks = 0; ks < KS; ++ks) { const f32x4* pp = (const f32x4*)(part + ((size_t)ks * MS + (row - MP)) * D) + lane;
#pragma unroll
                for (int j = 0; j < 8; ++j) sacc[j] += pp[64 * j]; }
            const f32x4* gt = (const f32x4*)(gate + (size_t)bi * NMOD) + lane; f32x4* xo = (f32x4*)(Xout + (size_t)row * D) + lane;
#pragma unroll
            for (int j = 0; j < 8; ++j) { v[j] += gt[64 * j] * sacc[j]; xo[64 * j] = v[j]; }
        }
        float s = 0.f;
#pragma unroll
        for (int j = 0; j < 8; ++j) s += (v[j].x * v[j].x + v[j].y * v[j].y) + (v[j].z * v[j].z + v[j].w * v[j].w);
        const float r = 1.0f / sqrtf(wave_sum(s) * (1.0f / D) + EPS);
        const f32x4* gp = (const f32x4*)g + lane; const f32x4* sh = (const f32x4*)(shiftb + (size_t)bi * NMOD) + lane; const f32x4* sc = (const f32x4*)(scaleb + (size_t)bi * NMOD) + lane;
        u32x2* o = (u32x2*)(H + (size_t)row * D) + lane;
#pragma unroll
        for (int j = 0; j < 8; ++j) { const f32x4 y = v[j] * r * gp[64 * j] * (1.0f + sc[64 * j]) + sh[64 * j]; u32x2 w; w.x = pk2(y.x, y.y); w.y = pk2(y.z, y.w); o[64 * j] = w; }
    }
}
__device__ __forceinline__ void ph_final_norm(float* X, const float* g, const float* part, int KS, const float* gate) {
    const int lane = threadIdx.x & 63, gw = blockIdx.x * 8 + (threadIdx.x >> 6), ngw = gridDim.x * 8;
    for (int row = gw; row < M; row += ngw) {
        f32x4* xr = (f32x4*)(X + (size_t)row * D) + lane;
        f32x4 v[8];
#pragma unroll
        for (int j = 0; j < 8; ++j) v[j] = xr[64 * j];
        if (row >= MP) {
            f32x4 sacc[8];
#pragma unroll
            for (int j = 0; j < 8; ++j) sacc[j] = (f32x4){0.f, 0.f, 0.f, 0.f};
            for (int ks = 0; ks < KS; ++ks) { const f32x4* pp = (const f32x4*)(part + ((size_t)ks * MS + (row - MP)) * D) + lane;
#pragma unroll
                for (int j = 0; j < 8; ++j) sacc[j] += pp[64 * j]; }
            const f32x4* gt = (const f32x4*)(gate + (size_t)row_bi(row) * NMOD) + lane;
#pragma unroll
            for (int j = 0; j < 8; ++j) v[j] += gt[64 * j] * sacc[j];
        }
        float s = 0.f;
#pragma unroll
        for (int j = 0; j < 8; ++j) s += (v[j].x * v[j].x + v[j].y * v[j].y) + (v[j].z * v[j].z + v[j].w * v[j].w);
        const float r = 1.0f / sqrtf(wave_sum(s) * (1.0f / D) + EPS);
        const f32x4* gp = (const f32x4*)g + lane;
#pragma unroll
        for (int j = 0; j < 8; ++j) xr[64 * j] = v[j] * r * gp[64 * j];
    }
}

__device__ __forceinline__ void ph_mixer(const float* const* in, unsigned char* ws, float* out, LAS unsigned char* lds) {
    const int tid = threadIdx.x, lane = tid & 63, wave = tid >> 6, fr = lane & 15, fq = lane >> 4;
    const bf16* U = (const bf16*)(ws + WS_R + R_U); const bf16* V = (const bf16*)(ws + WS_R + R_V); const bf16* XB = (const bf16*)(ws + WS_R + R_XB);
    bf16* CAT = (bf16*)(ws + WS_H);
    const float* ln_g = in[12]; const float* ln_b = in[13]; const float* b_s = in[15]; const float* pool_scale = in[17]; const float* hist = in[4];
    float* vs_out = out + OUT_VS;
    for (int unit = blockIdx.x; unit < 512 + 64; unit += gridDim.x) {
        const bool subu = unit >= 512; const int su = unit - 512;
        const int blk = subu ? 128 + (su >> 4) : unit >> 2, part = subu ? (su >> 2) & 3 : unit & 3, sub = su & 3;
        const int gi_lo = subu ? (part < 2 ? sub : sub >> 1) : 0, gi_hi = subu ? gi_lo + 1 : (part < 2 ? 4 : 2), dh_lo = subu ? (sub & 1) : 0, dh_hi = subu ? dh_lo + 1 : 2;
        const bool samp = blk >= 128;
        const int R0 = samp ? MP + (blk - 128) * 128 : blk * 128;
        if (part < 2) {
            LAS float* stat = (LAS float*)lds;
            LAS bf16* As = (LAS bf16*)(lds + 1024);
            LAS bf16* Bs = (LAS bf16*)(lds + 1024 + 34816);
            __syncthreads();
            for (int r = 0; r < 16; ++r) {
                const int t = wave * 16 + r;
                const u32x4* vp = (const u32x4*)(V + (size_t)(R0 + t) * 1024) + lane * 2;
                float f[16]; { float a[8], b[8]; unpack8(vp[0], a); unpack8(vp[1], b);
#pragma unroll
                    for (int j = 0; j < 8; ++j) { f[j] = a[j]; f[8 + j] = b[j]; } }
                float s = 0.f;
#pragma unroll
                for (int j = 0; j < 16; ++j) s += f[j];
                const float mean = wave_sum(s) * (1.0f / 1024.0f); float q = 0.f;
#pragma unroll
                for (int j = 0; j < 16; ++j) { const float d = f[j] - mean; q += d * d; }
                const float rstd = 1.0f / sqrtf(wave_sum(q) * (1.0f / 1024.0f) + EPS);
                if (lane == 0) { stat[2 * t] = mean; stat[2 * t + 1] = rstd; }
            }
            const bf16* wsrc = (const bf16*)(ws + (samp ? WS_WSB : WS_WSA));
            for (int gi = gi_lo; gi < gi_hi; ++gi) {
                const int g = part * 4 + gi;
                __syncthreads();
#pragma unroll
                for (int i = 0; i < 4; ++i) { const int e = tid + 512 * i, row = e >> 4, cc = e & 15;
                    *(LAS u32x4*)(As + row * 136 + cc * 8) = *(const u32x4*)(wsrc + (size_t)(g * 128 + row) * 128 + cc * 8); }
#pragma unroll
                for (int i = 0; i < 4; ++i) { const int e = tid + 512 * i, s = e >> 4, c8 = e & 15;
                    float f[8]; unpack8(*(const u32x4*)(V + (size_t)(R0 + s) * 1024 + g * 128 + c8 * 8), f);
                    const float mean = stat[2 * s], rstd = stat[2 * s + 1];
                    const f32x4 g0 = *(const f32x4*)(ln_g + g * 128 + c8 * 8), g1 = *(const f32x4*)(ln_g + g * 128 + c8 * 8 + 4);
                    const f32x4 b0 = *(const f32x4*)(ln_b + g * 128 + c8 * 8), b1 = *(const f32x4*)(ln_b + g * 128 + c8 * 8 + 4);
#pragma unroll
                    for (int j = 0; j < 4; ++j) { f[j] = (f[j] - mean) * rstd * g0[j] + b0[j]; f[4 + j] = (f[4 + j] - mean) * rstd * g1[j] + b1[j]; }
                    if (samp) { float* vo = vs_out + (size_t)(R0 - MP + s) * 1024 + g * 128 + c8 * 8;
                        *(f32x4*)vo = (f32x4){f[0], f[1], f[2], f[3]}; *(f32x4*)(vo + 4) = (f32x4){f[4], f[5], f[6], f[7]}; }
#pragma unroll
                    for (int j = 0; j < 8; j += 2) { const unsigned w = pk2(f[j], f[j + 1]); Bs[(c8 * 8 + j) * 136 + s] = (bf16)(w & 0xffffu); Bs[(c8 * 8 + j + 1) * 136 + s] = (bf16)(w >> 16); }
                }
                __syncthreads();
                f32x4 acc[8];
#pragma unroll
                for (int ct = 0; ct < 8; ++ct) acc[ct] = (f32x4){0.f, 0.f, 0.f, 0.f};
#pragma unroll
                for (int ks = 0; ks < 4; ++ks) {
                    const bf16x8 a = *(const LAS bf16x8*)(As + (wave * 16 + fr) * 136 + ks * 32 + fq * 8);
#pragma unroll
                    for (int ct = 0; ct < 8; ++ct) { const bf16x8 b = *(const LAS bf16x8*)(Bs + (ct * 16 + fr) * 136 + ks * 32 + fq * 8); acc[ct] = MFMA16(b, a, acc[ct]); }
                }
                {
                    LAS float* Ew = (LAS float*)(lds + 1024 + 2 * 34816) + wave * (16 * 132);
                    const int t = wave * 16 + fr; const float bsv = b_s[g * 128 + (samp ? (t & 31) : t)];
#pragma unroll
                    for (int ct = 0; ct < 8; ++ct) *(LAS f32x4*)(Ew + fr * 132 + ct * 16 + 4 * fq) = acc[ct] + bsv;
#pragma unroll
                    for (int it = 0; it < 4; ++it) { const int rr = it * 4 + (lane >> 4), c0 = (lane & 15) * 8, tt = wave * 16 + rr;
                        const f32x4 m0 = *(const LAS f32x4*)(Ew + rr * 132 + c0), m1 = *(const LAS f32x4*)(Ew + rr * 132 + c0 + 4);
                        float uf[8]; unpack8(*(const u32x4*)(U + (size_t)(R0 + tt) * 1024 + g * 128 + c0), uf);
                        float o[8] = {uf[0] * m0[0], uf[1] * m0[1], uf[2] * m0[2], uf[3] * m0[3], uf[4] * m1[0], uf[5] * m1[1], uf[6] * m1[2], uf[7] * m1[3]};
                        *(u32x4*)(CAT + (size_t)(R0 + tt) * D + g * 128 + c0) = pack8(o); }
                }
            }
        } else {
            LAS bf16* As = (LAS bf16*)lds;
            LAS bf16* Bs = (LAS bf16*)(lds + 67584);
            const bf16* WPT = (const bf16*)(ws + WS_WPT);
            for (int gi = gi_lo; gi < gi_hi; ++gi) {
                const int g = (part - 2) * 2 + gi, w = 2 << g;
                __syncthreads();
                {
                    const int tl = tid >> 5, co = tid & 31, t0 = tl * 8, cb = g * 256 + co * 8;
                    int sb = 0, i0 = 0, p0 = 0;
                    if (samp) { sb = (blk - 128) * 4 + (t0 >> 5); i0 = t0 & 31; } else { p0 = (R0 & 8191) + t0; }
                    auto ldrow = [&](int dt, float (&f)[8]) {
                        if (samp) { const int i = i0 + dt;
                            if (i >= 0) unpack8(*(const u32x4*)(XB + (size_t)(R0 + t0 + dt) * 1024 + cb), f);
                            else { const float* hp = hist + ((size_t)sb * 15 + (15 + i)) * 1024 + cb; const f32x4 a = *(const f32x4*)hp, b = *(const f32x4*)(hp + 4);
                                f[0] = a.x; f[1] = a.y; f[2] = a.z; f[3] = a.w; f[4] = b.x; f[5] = b.y; f[6] = b.z; f[7] = b.w; } }
                        else { if (p0 + dt >= 0) unpack8(*(const u32x4*)(XB + (size_t)(R0 + t0 + dt) * 1024 + cb), f);
                            else {
#pragma unroll
                                for (int j = 0; j < 8; ++j) f[j] = 0.f; } }
                    };
                    float S[8], x[8], y[8];
#pragma unroll
                    for (int j = 0; j < 8; ++j) S[j] = 0.f;
                    for (int j = 1; j < w; ++j) { ldrow(-j, x);
#pragma unroll
                        for (int q = 0; q < 8; ++q) S[q] += x[q]; }
                    for (int tt = 0; tt < 8; ++tt) {
                        ldrow(tt, x);
#pragma unroll
                        for (int q = 0; q < 8; ++q) S[q] += x[q];
                        const int pos = samp ? 2048 + i0 + tt : p0 + tt; const float inv = 1.0f / (float)(w < pos + 1 ? w : pos + 1);
                        float pv[8];
#pragma unroll
                        for (int q = 0; q < 8; ++q) pv[q] = S[q] * inv - x[q];
                        *(LAS u32x4*)(As + (t0 + tt) * 264 + co * 8) = pack8(pv);
                        ldrow(tt - w + 1, y);
#pragma unroll
                        for (int q = 0; q < 8; ++q) S[q] -= y[q];
                    }
                }
                for (int dh = dh_lo; dh < dh_hi; ++dh) {
                    __syncthreads();
#pragma unroll
                    for (int i = 0; i < 8; ++i) { const int e = tid + 512 * i, d = e >> 5, c8 = e & 31;
                        *(LAS u32x4*)(Bs + d * 264 + c8 * 8) = *(const u32x4*)(WPT + (size_t)(g * 256 + dh * 128 + d) * 256 + c8 * 8); }
                    __syncthreads();
                    f32x4 acc[8];
#pragma unroll
                    for (int ct = 0; ct < 8; ++ct) acc[ct] = (f32x4){0.f, 0.f, 0.f, 0.f};
#pragma unroll
                    for (int ks = 0; ks < 8; ++ks) {
                        const bf16x8 a = *(const LAS bf16x8*)(As + (wave * 16 + fr) * 264 + ks * 32 + fq * 8);
#pragma unroll
                        for (int ct = 0; ct < 8; ++ct) { const bf16x8 b = *(const LAS bf16x8*)(Bs + (ct * 16 + fr) * 264 + ks * 32 + fq * 8); acc[ct] = MFMA16(b, a, acc[ct]); }
                    }
                    __syncthreads();
                    {
                        LAS float* Ew = (LAS float*)(lds + 67584) + wave * (16 * 132);
#pragma unroll
                        for (int ct = 0; ct < 8; ++ct) *(LAS f32x4*)(Ew + fr * 132 + ct * 16 + 4 * fq) = acc[ct];
#pragma unroll
                        for (int it = 0; it < 4; ++it) { const int rr = it * 4 + (lane >> 4), c0 = (lane & 15) * 8, tt = wave * 16 + rr, dcol = g * 256 + dh * 128 + c0;
                            const f32x4 m0 = *(const LAS f32x4*)(Ew + rr * 132 + c0), m1 = *(const LAS f32x4*)(Ew + rr * 132 + c0 + 4);
                            const f32x4 p0 = *(const f32x4*)(pool_scale + dcol), p1 = *(const f32x4*)(pool_scale + dcol + 4);
                            float o[8] = {m0[0] * p0[0], m0[1] * p0[1], m0[2] * p0[2], m0[3] * p0[3], m1[0] * p1[0], m1[1] * p1[1], m1[2] * p1[2], m1[3] * p1[3]};
                            *(u32x4*)(CAT + (size_t)(R0 + tt) * D + 1024 + dcol) = pack8(o); }
                    }
                }
            }
        }
    }
}
template <int L> __device__ __forceinline__ void scores_unit(const bf16* Q, const bf16* K, bf16* P, int row0, int h, int lane) {
    constexpr int NT = L / 16; const int fr = lane & 15, fq = lane >> 4;
    const float sc = exp2f(-(float)L * head_log_g(h) * 1.4426950408889634f);
    for (int lt = 0; lt < NT; ++lt) {
        f32x4 acc[NT];
#pragma unroll
        for (int mt = 0; mt < NT; ++mt) acc[mt] = (f32x4){0.f, 0.f, 0.f, 0.f};
#pragma unroll
        for (int ks = 0; ks < 8; ++ks) {
            const bf16x8 a = *(const bf16x8*)(Q + (((size_t)(row0 >> 4) + lt) * 8 + ks) * 512 + lane * 8);
#pragma unroll
            for (int mt = 0; mt < NT; ++mt) { const bf16x8 b = *(const bf16x8*)(K + (size_t)(row0 + mt * 16 + fr) * 256 + ks * 32 + fq * 8); acc[mt] = MFMA16(b, a, acc[mt]); }
        }
        const int l = lt * 16 + fr;
#pragma unroll
        for (int mt = 0; mt < NT; ++mt) { const int m0 = mt * 16 + 4 * fq; float v[4];
#pragma unroll
            for (int r = 0; r < 4; ++r) v[r] = (l >= m0 + r) ? acc[mt][r] * sc : 0.f;
            u32x2 o; o.x = pk2(v[0], v[1]); o.y = pk2(v[2], v[3]);
            if (L == 64) *(u32x2*)(P + ((lt * 2 + (mt >> 1)) * 64 + ((mt & 1) * 2 + (fq >> 1)) * 16 + fr) * 8 + (fq & 1) * 4) = o;
            else *(u32x2*)(P + l * L + m0) = o; }
    }
}
__device__ __forceinline__ void ph_scores(unsigned char* ws) {
    const int lane = threadIdx.x & 63, gw = blockIdx.x * 8 + (threadIdx.x >> 6), ngw = gridDim.x * 8;
    const bf16* Q = (const bf16*)(ws + WS_R + R_Q); const bf16* K = (const bf16*)(ws + WS_R + R_K);
    for (int unit = gw; unit < 2048 + 128; unit += ngw) {
        if (unit < 2048) scores_unit<64>(Q, K, (bf16*)(ws + WS_PP) + (size_t)unit * 4096, hm_row((unit >> 3) * 64, unit & 7), unit & 7, lane);
        else { const int su = unit - 2048; scores_unit<32>(Q, K, (bf16*)(ws + WS_PS) + (size_t)su * 1024, hm_row(MP + (su >> 3) * 32, su & 7), su & 7, lane); }
    }
}

constexpr int RQP = 272, RVP = 80, RPP = 72;
constexpr int R_QS = 0, R_KS = R_QS + 64 * RQP * 2, R_VS = R_KS + 64 * RQP * 2, R_PS = R_VS + 64 * RVP * 2, R_ST = R_PS + 64 * RPP * 2, R_LDS_END = R_ST + 64 * RQP * 2;
static_assert(R_LDS_END <= 131072, "retention LDS");
__device__ __forceinline__ bf16x8 tr_frag(const LAS bf16* base, int pitch) {
    const s16x4 lo = __builtin_amdgcn_ds_read_tr16_b64_v4i16((LAS s16x4*)(base)), hi = __builtin_amdgcn_ds_read_tr16_b64_v4i16((LAS s16x4*)(base + 4 * pitch));
    return (bf16x8){lo[0], lo[1], lo[2], lo[3], hi[0], hi[1], hi[2], hi[3]};
}
template <int L> __device__ __forceinline__ void ret_unit(const bf16* Qd, const bf16* Kd, const bf16* Vv, const bf16* P, size_t pstride, bf16* O, int row0, int nchunks, int h, int e0,
                                                         const float* S0, float* Sout, LAS unsigned char* lds) {
    const int tid = threadIdx.x, lane = tid & 63, wave = tid >> 6, fr = lane & 15, fq = lane >> 4, tq = (lane & 15) >> 2, tp = lane & 3;
    LAS bf16* Qs = (LAS bf16*)(lds + R_QS); LAS bf16* Ks = (LAS bf16*)(lds + R_KS); LAS bf16* Vs = (LAS bf16*)(lds + R_VS); LAS bf16* Ps = (LAS bf16*)(lds + R_PS); LAS bf16* ST = (LAS bf16*)(lds + R_ST);
    constexpr int NQ = L / 16, TPW = L / 32, NKS = L / 32;
    constexpr bool VALL = (L == 64);
    const float gL = exp2f((float)L * head_log_g(h) * 1.4426950408889634f);
    f32x4 S[2][4];
#pragma unroll
    for (int dti = 0; dti < 2; ++dti)
#pragma unroll
        for (int et = 0; et < 4; ++et)
#pragma unroll
            for (int r = 0; r < 4; ++r) S[dti][et][r] = S0 ? S0[(size_t)((2 * wave + dti) * 16 + 4 * fq + r) * 512 + e0 + et * 16 + fr] : 0.f;
    u32x4 rq[NQ], rk[NQ], rv, rp;
    rv = (u32x4){0u, 0u, 0u, 0u}; rp = rv;
    const bool vact = VALL || tid < 8 * L, pact = tid < L * (L / 8);
#define RET_LOAD(c) do { const size_t rb = (size_t)row0 + (size_t)(c) * L; \
        _Pragma("unroll") for (int i = 0; i < NQ; ++i) { const int e = tid + 512 * i, r = e >> 5, pc = e & 31; \
            rq[i] = *(const u32x4*)(Qd + rb * 256 + (size_t)e * 8); rk[i] = *(const u32x4*)(Kd + (rb + r) * 256 + pc * 8); } \
        if (vact) rv = *(const u32x4*)(Vv + (rb + (tid >> 3)) * 512 + e0 + (tid & 7) * 8); \
        if (pact) rp = *(const u32x4*)(P + (size_t)(c) * pstride + (size_t)(tid / (L / 8)) * L + (tid % (L / 8)) * 8); } while (0)
    RET_LOAD(0);
    for (int c = 0; c < nchunks; ++c) {
        __syncthreads();
#pragma unroll
        for (int i = 0; i < NQ; ++i) { const int e = tid + 512 * i, r = e >> 5, pc = e & 31; *(LAS u32x4*)(Qs + ((e >> 9) * 16 + (e & 15)) * RQP + ((e >> 6) & 7) * 32 + ((e >> 4) & 3) * 8) = rq[i]; *(LAS u32x4*)(Ks + r * RQP + pc * 8) = rk[i]; }
        if (vact) *(LAS u32x4*)(Vs + (tid >> 3) * RVP + (tid & 7) * 8) = rv;
        if (pact) *(LAS u32x4*)(Ps + (tid / (L / 8)) * RPP + (tid % (L / 8)) * 8) = rp;
#pragma unroll
        for (int dti = 0; dti < 2; ++dti)
#pragma unroll
            for (int et = 0; et < 4; ++et) { u32x2 w; w.x = pk2(S[dti][et][0], S[dti][et][1]); w.y = pk2(S[dti][et][2], S[dti][et][3]);
                *(LAS u32x2*)(ST + (et * 16 + fr) * RQP + (2 * wave + dti) * 16 + 4 * fq) = w; }
        __syncthreads();
        if (c + 1 < nchunks) RET_LOAD(c + 1);
#pragma unroll
        for (int i = 0; i < TPW; ++i) {
            const int t = wave * TPW + i, lt = t >> 2, et = t & 3;
            f32x4 o = (f32x4){0.f, 0.f, 0.f, 0.f};
#pragma unroll
            for (int ks = 0; ks < 8; ++ks) { const bf16x8 a = *(const LAS bf16x8*)(Qs + (lt * 16 + fr) * RQP + ks * 32 + fq * 8), b = *(const LAS bf16x8*)(ST + (et * 16 + fr) * RQP + ks * 32 + fq * 8); o = MFMA16(b, a, o); }
#pragma unroll
            for (int ks = 0; ks < NKS; ++ks) { const bf16x8 a = *(const LAS bf16x8*)(Ps + (lt * 16 + fr) * RPP + ks * 32 + fq * 8), b = tr_frag(Vs + (ks * 32 + 8 * fq + tq) * RVP + et * 16 + 4 * tp, RVP); o = MFMA16(b, a, o); }
            u32x2 w; w.x = pk2(o[0], o[1]); w.y = pk2(o[2], o[3]);
            *(u32x2*)(O + ((size_t)row0 + (size_t)c * L + lt * 16 + fr) * 512 + e0 + et * 16 + 4 * fq) = w;
        }
#pragma unroll
        for (int dti = 0; dti < 2; ++dti)
#pragma unroll
            for (int et = 0; et < 4; ++et) S[dti][et] = S[dti][et] * gL;
#pragma unroll
        for (int ks = 0; ks < NKS; ++ks) {
            bf16x8 bv[4];
#pragma unroll
            for (int et = 0; et < 4; ++et) bv[et] = tr_frag(Vs + (ks * 32 + 8 * fq + tq) * RVP + et * 16 + 4 * tp, RVP);
#pragma unroll
            for (int dti = 0; dti < 2; ++dti) { const bf16x8 ak = tr_frag(Ks + (ks * 32 + 8 * fq + tq) * RQP + (2 * wave + dti) * 16 + 4 * tp, RQP);
#pragma unroll
                for (int et = 0; et < 4; ++et) S[dti][et] = MFMA16(ak, bv[et], S[dti][et]); }
        }
    }
#undef RET_LOAD
#pragma unroll
    for (int dti = 0; dti < 2; ++dti)
#pragma unroll
        for (int et = 0; et < 4; ++et)
#pragma unroll
            for (int r = 0; r < 4; ++r) Sout[(size_t)((2 * wave + dti) * 16 + 4 * fq + r) * 512 + e0 + et * 16 + fr] = S[dti][et][r];
}

constexpr int P_KB = 0, P_VB = 2 * 64 * RQP * 2, P_VP = 48, P_ST = P_VB + 2 * 64 * P_VP * 2, P_END = P_ST + 2 * 32 * RQP * 2;
static_assert(P_END <= 131072, "prompt retention LDS");
template <int VAR> __device__ __forceinline__ void ret_prompt(const bf16* Qd, const bf16* Kd, const bf16* Vv, const bf16* P, bf16* O, int row0, int h, int e0, float* Sout, LAS unsigned char* lds) {
    const int tid = threadIdx.x, lane = tid & 63, wave = tid >> 6, fr = lane & 15, fq = lane >> 4, tq = (lane & 15) >> 2, tp = lane & 3;
    constexpr int NCH = 128;
    const float gL = exp2f(64.0f * head_log_g(h) * 1.4426950408889634f);
    const int lt = wave >> 1, et_o = wave & 1;
    f32x4 S[2][2], ocar = (f32x4){0.f, 0.f, 0.f, 0.f};
#pragma unroll
    for (int a = 0; a < 2; ++a)
#pragma unroll
        for (int b = 0; b < 2; ++b) S[a][b] = (f32x4){0.f, 0.f, 0.f, 0.f};
    u32x4 rkA[4], rkB[4], rvA, rvB; rvA = (u32x4){0u, 0u, 0u, 0u}; rvB = rvA;
    bf16x8 qA[4], qB[4], pA[1], pB[1];
    const char* kbase = (const char*)(Kd + (size_t)row0 * 256); const char* vbase = (const char*)(Vv + (size_t)row0 * 512 + e0);
    const char* qbase = (const char*)(Qd + (size_t)row0 * 256); const char* pbase = (const char*)P; char* obase = (char*)(O + (size_t)row0 * 512 + e0);
    unsigned koff[4];
#pragma unroll
    for (int i = 0; i < 4; ++i) { const int e = tid + 512 * i; koff[i] = (unsigned)(e * 16); }
    const unsigned voff = (unsigned)((((tid & 255) >> 2) * 512 + (tid & 3) * 8) * 2), qoff = (unsigned)(((lt * 8 + et_o * 4) * 512 + lane * 8) * 2), poff = (unsigned)(((lt * 2 + et_o) * 512 + lane * 8) * 2);
    const unsigned ooff = (unsigned)(((lt * 16 + fr) * 512 + et_o * 16 + 4 * fq) * 2);
    unsigned klds[4];
#pragma unroll
    for (int i = 0; i < 4; ++i) { const int e = tid + 512 * i; klds[i] = (unsigned)(P_KB + ((e >> 5) * RQP + (e & 31) * 8) * 2); }
    const unsigned vlds = (unsigned)(P_VB + (((tid & 255) >> 2) * P_VP + (tid & 3) * 8) * 2);
    LAS unsigned char* xo = lds + P_END;
    const unsigned xwr = (unsigned)(((lt * 2 + et_o) * 64 + lane) * 16), xrd = (unsigned)(((lt * 2 + (et_o ^ 1)) * 64 + lane) * 16);
#define RP_LOADKV(rk, rv, c) do { const char* kc_ = kbase + (size_t)(c) * (64 * 256 * 2); const char* vc_ = vbase + (size_t)(c) * (64 * 512 * 2); \
        _Pragma("unroll") for (int i = 0; i < 4; ++i) rk[i] = *(const u32x4*)(kc_ + koff[i]); rv = *(const u32x4*)(vc_ + voff); } while (0)
#define RP_STOREKV(rk, rv, b) do { _Pragma("unroll") for (int i = 0; i < 4; ++i) *(LAS u32x4*)(lds + (b) * (64 * RQP * 2) + klds[i]) = rk[i]; \
        *(LAS u32x4*)(lds + (b) * (64 * P_VP * 2) + vlds) = rv; } while (0)
#define RP_LOADQP(dq, dp, c) do { const char* qc_ = qbase + (size_t)(c) * (64 * 256 * 2) + qoff; const char* pc_ = pbase + (size_t)(c) * (8 * 4096 * 2) + poff; \
        _Pragma("unroll") for (int ks = 0; ks < 4; ++ks) dq[ks] = *(const bf16x8*)(qc_ + ks * 1024); \
        dp[0] = *(const bf16x8*)(pc_); } while (0)
#define RP_STOREST(b) do { _Pragma("unroll") for (int dti = 0; dti < 2; ++dti) _Pragma("unroll") for (int et = 0; et < 2; ++et) { u32x2 w; w.x = pk2(S[dti][et][0], S[dti][et][1]); w.y = pk2(S[dti][et][2], S[dti][et][3]); \
        *(LAS u32x2*)(lds + P_ST + (b) * (32 * RQP * 2) + ((et * 16 + fr) * RQP + (2 * wave + dti) * 16 + 4 * fq) * 2) = w; } } while (0)
#define RP_BODY(c, cur, rkX, rvX, qX, pX) do { \
        asm volatile("s_waitcnt lgkmcnt(0)" ::: "memory"); __builtin_amdgcn_s_barrier(); asm volatile("" ::: "memory"); \
        RP_STOREKV(rkX, rvX, (cur) ^ 1); \
        if (VAR != 2) { const int ck = (c) + 3 < NCH ? (c) + 3 : NCH - 1; RP_LOADKV(rkX, rvX, ck); } \
        const LAS bf16* Kc = (const LAS bf16*)(lds + P_KB + (cur) * (64 * RQP * 2)); const LAS bf16* Vc = (const LAS bf16*)(lds + P_VB + (cur) * (64 * P_VP * 2)); \
        const LAS bf16* STp = (const LAS bf16*)(lds + P_ST + ((cur) ^ 1) * (32 * RQP * 2)); \
        bf16x8 bv[2][2], sb[4]; \
        _Pragma("unroll") for (int ks = 0; ks < 2; ++ks) _Pragma("unroll") for (int et = 0; et < 2; ++et) bv[ks][et] = tr_frag(Vc + (ks * 32 + 8 * fq + tq) * P_VP + et * 16 + 4 * tp, P_VP); \
        _Pragma("unroll") for (int a = 0; a < 2; ++a) _Pragma("unroll") for (int b = 0; b < 2; ++b) S[a][b] = S[a][b] * gL; \
        _Pragma("unroll") for (int ks = 0; ks < 2; ++ks) { bf16x8 ak[2]; \
          _Pragma("unroll") for (int dti = 0; dti < 2; ++dti) ak[dti] = tr_frag(Kc + (ks * 32 + 8 * fq + tq) * RQP + (2 * wave + dti) * 16 + 4 * tp, RQP); \
          _Pragma("unroll") for (int dti = 0; dti < 2; ++dti) _Pragma("unroll") for (int et = 0; et < 2; ++et) S[dti][et] = MFMA16(ak[dti], bv[ks][et], S[dti][et]); } \
        RP_STOREST(cur); \
        {   \
          const f32x4 opart = *(const LAS f32x4*)(xo + ((cur) ^ 1) * 8192 + xrd); \
          { const f32x4 o = ocar + opart; u32x2 w; w.x = pk2(o[0], o[1]); w.y = pk2(o[2], o[3]);     \
            *(u32x2*)(obase + (size_t)((c) > 0 ? (c) - 1 : 0) * (64 * 512 * 2) + ooff) = w; } \
          f32x4 om = (f32x4){0.f, 0.f, 0.f, 0.f}, ot = om; \
          _Pragma("unroll") for (int ks = 0; ks < 4; ++ks) { sb[ks] = *(const LAS bf16x8*)(STp + (et_o * 16 + fr) * RQP + (et_o * 4 + ks) * 32 + fq * 8); } \
          _Pragma("unroll") for (int ks = 0; ks < 4; ++ks) om = MFMA16(sb[ks], qX[ks], om); \
          _Pragma("unroll") for (int ks = 0; ks < 4; ++ks) { sb[ks] = *(const LAS bf16x8*)(STp + ((et_o ^ 1) * 16 + fr) * RQP + (et_o * 4 + ks) * 32 + fq * 8); } \
          { const bf16x8 bm = tr_frag(Vc + (et_o * 32 + 8 * fq + tq) * P_VP + et_o * 16 + 4 * tp, P_VP), bt = tr_frag(Vc + (et_o * 32 + 8 * fq + tq) * P_VP + (et_o ^ 1) * 16 + 4 * tp, P_VP); \
            om = MFMA16(bm, pX[0], om); ot = MFMA16(bt, pX[0], ot); } \
          _Pragma("unroll") for (int ks = 0; ks < 4; ++ks) ot = MFMA16(sb[ks], qX[ks], ot); \
          ocar = om; *(LAS f32x4*)(xo + (cur) * 8192 + xwr) = ot; } \
        if (VAR != 1) { const int cq = (c) + 2 < NCH ? (c) + 2 : NCH - 1; RP_LOADQP(qX, pX, cq); } \
        } while (0)
    __syncthreads();
    RP_LOADKV(rkA, rvA, 0); RP_STOREKV(rkA, rvA, 0); RP_STOREST(1);
    RP_LOADKV(rkA, rvA, 1); RP_LOADKV(rkB, rvB, 2); RP_LOADQP(qA, pA, 0); RP_LOADQP(qB, pB, 1);
#pragma nounroll
    for (int c = 0; c < NCH; c += 2) {
        RP_BODY(c, 0, rkA, rvA, qA, pA);
        __builtin_amdgcn_sched_barrier(0);
        RP_BODY(c + 1, 1, rkB, rvB, qB, pB);
        __builtin_amdgcn_sched_barrier(0);
    }
#undef RP_BODY
    asm volatile("s_waitcnt lgkmcnt(0)" ::: "memory"); __builtin_amdgcn_s_barrier(); asm volatile("" ::: "memory");
    { const f32x4 opart = *(const LAS f32x4*)(xo + ((NCH - 1) & 1) * 8192 + xrd); const f32x4 o = ocar + opart; u32x2 w; w.x = pk2(o[0], o[1]); w.y = pk2(o[2], o[3]);
      *(u32x2*)(obase + (size_t)(NCH - 1) * (64 * 512 * 2) + ooff) = w; }
#undef RP_LOADKV
#undef RP_STOREKV
#undef RP_LOADQP
#undef RP_STOREST
#pragma unroll
    for (int dti = 0; dti < 2; ++dti)
#pragma unroll
        for (int et = 0; et < 2; ++et)
#pragma unroll
            for (int r = 0; r < 4; ++r) Sout[(size_t)((2 * wave + dti) * 16 + 4 * fq + r) * 512 + e0 + et * 16 + fr] = S[dti][et][r];
}
__device__ __forceinline__ void ph_retention(const float* const* in, unsigned char* ws, float* out, LAS unsigned char* lds) {
    const bf16* Q = (const bf16*)(ws + WS_R + R_Q); const bf16* K = (const bf16*)(ws + WS_R + R_K); const bf16* V = (const bf16*)(ws + WS_R + R_VV); bf16* O = (bf16*)(ws + WS_R + R_O);
#if DUP_PHASE >= 200
    for (int task = blockIdx.x; task < 256; task += gridDim.x) {
        const int xcd = task & 7, idx = task >> 3, bh = xcd * 2 + (idx >> 4), sl = idx & 15, b = bh >> 3, h = bh & 7;
        ret_prompt<DUP_PHASE - 200>(Q, K, V, (const bf16*)(ws + WS_PP) + ((size_t)(b * 128) * 8 + h) * 4096, (bf16*)(ws + WS_H) - (size_t)bh * SEQ * 512, bh * SEQ, h, sl * 32, (float*)(ws + WS_H + (16u << 20)), lds);
    }
    __syncthreads();
#endif
    for (int task = blockIdx.x; task < 256; task += gridDim.x) {
        const int xcd = task & 7, idx = task >> 3, bh = xcd * 2 + (idx >> 4), sl = idx & 15, b = bh >> 3, h = bh & 7;
        ret_prompt<0>(Q, K, V, (const bf16*)(ws + WS_PP) + ((size_t)(b * 128) * 8 + h) * 4096, O, bh * SEQ, h, sl * 32, out + OUT_RETP + (size_t)bh * 256 * 512, lds);
    }
#if DUP_PHASE == 111
    for (int rep_ = 0; rep_ < 2; ++rep_)
#endif
    for (int task = blockIdx.x; task < 256; task += gridDim.x) {
        const int su = task >> 1, sb = su >> 3, h = su & 7;
        for (int sl = (task & 1) * 4; sl < (task & 1) * 4 + 4; ++sl)
            ret_unit<32>(Q, K, V, (const bf16*)(ws + WS_PS) + (size_t)su * 1024, 0, O, MP * 8 + su * 32, 1, h, sl * 64, in[5] + (size_t)su * 256 * 512, out + OUT_RETS + (size_t)su * 256 * 512, lds);
    }
}
__device__ __forceinline__ void ph_gate_norm(unsigned char* ws) {
    const int lane = threadIdx.x & 63, gw = blockIdx.x * 8 + (threadIdx.x >> 6), ngw = gridDim.x * 8;
    bf16* G = (bf16*)(ws + WS_R + R_G); const bf16* O = (const bf16*)(ws + WS_R + R_O);
    for (int row = gw; row < M; row += ngw) {
#pragma unroll
        for (int hh = 0; hh < 8; ++hh) {
            const size_t off = (size_t)row * VW + hh * 512 + lane * 8, ooff = (size_t)hm_row(row, hh) * 512 + lane * 8;
            float o[8], g[8]; unpack8(*(const u32x4*)(O + ooff), o); unpack8(*(const u32x4*)(G + off), g);
            float s = 0.f;
#pragma unroll
            for (int j = 0; j < 8; ++j) s += o[j] * o[j];
            const float r = 1.0f / sqrtf(wave_sum(s) * (1.0f / 512.0f) + EPS);
#pragma unroll
            for (int j = 0; j < 8; ++j) g[j] = g[j] * o[j] * r;
            *(u32x4*)(G + off) = pack8(g);
        }
    }
}

#define XB_TMO      128
#define XB_XCNT(j)  (256  + 64 * (j))
#define XB_XSUB(j)  (1280 + 64 * (j))
#define XB_XGEN(j)  (2304 + 64 * (j))
#define XB_TOP      3328
#define XB_TOPGEN   3392
#define XCD_BAR_WORDS 3456
#define XB_SPIN_CAP (1u << 18)

__device__ __forceinline__ unsigned xb_ld(unsigned* p)              { return __hip_atomic_load(p, __ATOMIC_RELAXED, __HIP_MEMORY_SCOPE_AGENT); }
__device__ __forceinline__ unsigned xb_add(unsigned* p, unsigned v) { return __hip_atomic_fetch_add(p, v, __ATOMIC_RELAXED, __HIP_MEMORY_SCOPE_AGENT); }
__device__ __forceinline__ unsigned xb_xcc_id() { return (unsigned)__builtin_amdgcn_s_getreg((3 << 11) | 20) & 0xFu; }
#define XB_SPIN(cond, bar) do { unsigned _sp = 0; while (cond) { __builtin_amdgcn_s_sleep(1); \
    if ((++_sp & 255u) == 0u) { if (xb_ld(&(bar)[XB_TMO])) break; if (_sp > XB_SPIN_CAP) { atomicAdd(&(bar)[XB_TMO], 1u); break; } } } } while (0)

struct XcdBarrier {
    unsigned* bar; unsigned x;
    volatile LAS unsigned* st;
};

__device__ __forceinline__ XcdBarrier xcd_barrier_post(unsigned* bar, volatile LAS unsigned* st) {
    XcdBarrier b; b.bar = bar; b.x = xb_xcc_id(); b.st = st;
    if (threadIdx.x == 0) (void)xb_add(&bar[XB_XCNT(b.x)], 1u);
    return b;
}
__device__ __forceinline__ void xcd_barrier_complete(unsigned* bar, unsigned x, unsigned& nloc, unsigned& nx) {
    const unsigned G = gridDim.x * gridDim.y * gridDim.z;
    unsigned sum, cnt, mine, sp = 0u;
    for (;;) {
        sum = 0u; cnt = 0u; mine = 0u;
#pragma unroll
        for (unsigned j = 0; j < 16; ++j) { const unsigned c = xb_ld(&bar[XB_XCNT(j)]); sum += c; cnt += (c > 0u) ? 1u : 0u; mine = (j == x) ? c : mine; }
        if (sum == G) break;
        __builtin_amdgcn_s_sleep(1);
        if ((++sp & 255u) == 0u) { if (xb_ld(&bar[XB_TMO])) break; if (sp > XB_SPIN_CAP) { atomicAdd(&bar[XB_TMO], 1u); break; } }
    }
    nloc = mine > 0u ? mine : 1u; nx = cnt > 0u ? cnt : 1u;
}

__device__ __forceinline__ void xcd_barrier(const XcdBarrier& b) {
    asm volatile("s_waitcnt vmcnt(0)" ::: "memory");
    __syncthreads();
    if (threadIdx.x == 0) {
        unsigned* bar = b.bar;
        __builtin_amdgcn_s_waitcnt(0);
        unsigned nloc = b.st[0], nx = b.st[1];
        if (nloc == 0u) { xcd_barrier_complete(bar, b.x, nloc, nx); b.st[0] = nloc; b.st[1] = nx; }
        const unsigned old = xb_add(&bar[XB_XSUB(b.x)], 1u);
        const unsigned gen = old / nloc;
        if (old + 1u == (gen + 1u) * nloc) {
            __builtin_amdgcn_fence(__ATOMIC_RELEASE, "agent");
            asm volatile("s_waitcnt vmcnt(0)" ::: "memory");
            const unsigned og = xb_add(&bar[XB_TOP], 1u);
            const unsigned tg = og / nx;
            if (og + 1u == (tg + 1u) * nx) xb_add(&bar[XB_TOPGEN], 1u);
            else XB_SPIN(xb_ld(&bar[XB_TOPGEN]) == tg, bar);
            __builtin_amdgcn_fence(__ATOMIC_ACQUIRE, "agent");
            xb_add(&bar[XB_XGEN(b.x)], 1u);
            asm volatile("s_waitcnt vmcnt(0)" ::: "memory");
        } else {
            XB_SPIN(xb_ld(&bar[XB_XGEN(b.x)]) == gen, bar);
            __builtin_amdgcn_fence(__ATOMIC_ACQUIRE, "agent");
            asm volatile("s_waitcnt vmcnt(0)" ::: "memory");
        }
    }
    __syncthreads();
}

struct Args { const float* in[23]; float* out; unsigned char* ws; int ph_lo, ph_hi; };
static_assert(sizeof(Args) == 23 * 8 + 8 + 8 + 8, "Args has no padding");

template <class Epi> __device__ __forceinline__ void run_gemm(LAS unsigned char* lds, const bf16* A, const bf16* Bt, int N, int K, const Epi& E) {
    pg8::Gemm g{A, Bt, M, N, K, K}; pg8::StaticOrder S; S.init(M, N, (int)gridDim.x, (int)blockIdx.x);
    pg8::gemm_phase<Epi, pg8::StaticOrder, true, true>(lds, g, S, E);
}
__device__ __forceinline__ void run_gemm_res(LAS unsigned char* lds, const bf16* A, const bf16* Bt, int K, const EpiRes& E, float* PART, int KS) {
    { pg8::Gemm g{A, Bt, MP, D, K, K}; pg8::StaticOrder S; S.init(MP, D, (int)gridDim.x, (int)blockIdx.x);
      pg8::gemm_phase<EpiRes, pg8::StaticOrder, true, true>(lds, g, S, E); }
    { const int KL = K / KS; pg8::Gemm g{A, Bt, M, D, K, KL}; SplitOrder S{D / 256, KS, KL, (int)gridDim.x, (int)blockIdx.x}; EpiPartial EP{PART, KL};
      pg8::gemm_phase<EpiPartial, SplitOrder, true, true>(lds, g, S, EP); }
}

__global__ void __launch_bounds__(512, 2) mega_fwd(Args a) {
    extern __shared__ __attribute__((aligned(16))) unsigned char lds_raw[];
    LAS unsigned char* lds = (LAS unsigned char*)lds_raw;
    cg::grid_group grid = cg::this_grid();
    unsigned char* ws = a.ws; float* out = a.out;
    const int lo = a.ph_lo, hi = a.ph_hi;
#define IN(k) (lo <= (k) && (k) < hi)
#ifndef DUP_PHASE
#define DUP_PHASE -1
#endif
#define SEAM(k) do { if (IN(k) && IN((k) + 1)) { if ((k) == 0) { asm volatile("s_waitcnt vmcnt(0) lgkmcnt(0)" ::: "memory"); grid.sync(); } else xcd_barrier(xbar); } } while (0)
    volatile LAS unsigned* xst = (volatile LAS unsigned*)(lds + LDS_BYTES);
    if (threadIdx.x < 2) xst[threadIdx.x] = 0u;
    __syncthreads();
    XcdBarrier xbar = xcd_barrier_post((unsigned*)(ws + WS_BAR), xst);
    float* mods = (float*)(ws + WS_MODS);
    bf16* H = (bf16*)(ws + WS_H);
    unsigned char* wb = ws + WS_W; unsigned char* R = ws + WS_R;
    float* X = out + OUT_Y;
    float* PART = (float*)(R + R_O);
    constexpr int KS2 = 8, KS4 = 8, KS5 = 11;

    if (IN(0)) ph_prologue(a.in, ws, lds);
#if DUP_PHASE == 0
    __syncthreads();
    if (IN(0)) ph_prologue(a.in, ws, lds);
#endif
    SEAM(0);
    if (IN(1)) ph_norm(a.in[0], a.in[1], a.in[8], mods + 0 * D, mods + 1 * D, H, nullptr, 0, nullptr, nullptr);
#if DUP_PHASE == 1
    __syncthreads();
    if (IN(1)) ph_norm(a.in[0], a.in[1], a.in[8], mods + 0 * D, mods + 1 * D, H, nullptr, 0, nullptr, nullptr);
#endif
    SEAM(1);
    if (IN(2)) { EpiInAB E{(bf16*)(R + R_U), (bf16*)(R + R_V), (bf16*)(R + R_XB), out + OUT_POOLP, out + OUT_POOLS};
        run_gemm(lds, H, (const bf16*)(wb + W0_IN), 3072, D, E); }
#if DUP_PHASE == 2
    __syncthreads();
    if (IN(2)) { EpiInAB E{(bf16*)(R + R_U), (bf16*)(R + R_V), (bf16*)(R + R_XB), out + OUT_POOLP, out + OUT_POOLS};
        run_gemm(lds, H, (const bf16*)(wb + W0_IN), 3072, D, E); }
#endif
    SEAM(2);
    if (IN(3)) ph_mixer(a.in, ws, out, lds);
#if DUP_PHASE == 3
    __syncthreads();
    if (IN(3)) ph_mixer(a.in, ws, out, lds);
#endif
    SEAM(3);
    if (IN(4)) { EpiRes E{a.in[0], a.in[1], X, mods + 2 * D}; run_gemm_res(lds, H, (const bf16*)(wb + W0_OUT), D, E, PART, KS2); }
    SEAM(4);
    if (IN(5)) ph_norm(X, a.in[1], a.in[9], mods + 3 * D, mods + 4 * D, H, PART, KS2, mods + 2 * D, X);
    SEAM(5);
    if (IN(6)) { EpiSwiGLU E{(bf16*)(R + R_ACT)}; run_gemm(lds, H, (const bf16*)(wb + W0_GU), 2 * DFF, D, E); }
#if DUP_PHASE == 6
    __syncthreads();
    if (IN(6)) { EpiSwiGLU E{(bf16*)(R + R_ACT)}; run_gemm(lds, H, (const bf16*)(wb + W0_GU), 2 * DFF, D, E); }
#endif
    SEAM(6);
    if (IN(7)) { EpiRes E{X, X + (size_t)MP * D, X, mods + 5 * D}; run_gemm_res(lds, (const bf16*)(R + R_ACT), (const bf16*)(wb + W0_DN), DFF, E, PART, KS5); }
    SEAM(7);
    if (IN(8)) {
        ph_norm(X, X + (size_t)MP * D, a.in[8] + D, mods + (size_t)NBI * NMOD + 0 * D, mods + (size_t)NBI * NMOD + 1 * D, H, PART, KS5, mods + 5 * D, X);
        __syncthreads();
        const int lane = threadIdx.x & 63, wave = threadIdx.x >> 6; LAS float* scr = (LAS float*)(lds + wave * 16384);
        const int gw = blockIdx.x * 8 + wave, ngw = gridDim.x * 8;
        convert_weight(a.in[19], D, NQKVG, (bf16*)(wb + W1_IN), 0, scr, lane, gw, ngw);
        convert_weight(a.in[20], VW, D, (bf16*)(wb + W1_OUT), 0, scr, lane, gw, ngw);
        convert_weight(a.in[21] + (size_t)D * 2 * DFF, D, 2 * DFF, (bf16*)(wb + W1_GU), 1, scr, lane, gw, ngw);
        convert_weight(a.in[22] + (size_t)DFF * D, DFF, D, (bf16*)(wb + W1_DN), 0, scr, lane, gw, ngw);
    }
    SEAM(8);
    if (IN(9)) { EpiQKVG E{(bf16*)(R + R_Q), (bf16*)(R + R_K), (bf16*)(R + R_VV), (bf16*)(R + R_G), (const float*)(ws + WS_COS), (const float*)(ws + WS_SIN)};
        run_gemm(lds, H, (const bf16*)(wb + W1_IN), NQKVG, D, E); }
#if DUP_PHASE == 9
    __syncthreads();
    if (IN(9)) { EpiQKVG E{(bf16*)(R + R_Q), (bf16*)(R + R_K), (bf16*)(R + R_VV), (bf16*)(R + R_G), (const float*)(ws + WS_COS), (const float*)(ws + WS_SIN)};
        run_gemm(lds, H, (const bf16*)(wb + W1_IN), NQKVG, D, E); }
#endif
    SEAM(9);
    if (IN(10)) ph_scores(ws);
#if DUP_PHASE == 10
    __syncthreads();
    if (IN(10)) ph_scores(ws);
#endif
    SEAM(10);
    if (IN(11)) ph_retention(a.in, ws, out, lds);
#if DUP_PHASE == 11
    __syncthreads();
    if (IN(11)) ph_retention(a.in, ws, out, lds);
#endif
    SEAM(11);
    if (IN(12)) ph_gate_norm(ws);
    SEAM(12);
    if (IN(13)) { EpiRes E{X, X + (size_t)MP * D, X, mods + (size_t)NBI * NMOD + 2 * D}; run_gemm_res(lds, (const bf16*)(R + R_G), (const bf16*)(wb + W1_OUT), VW, E, PART, KS4); }
    SEAM(13);
    if (IN(14)) ph_norm(X, X + (size_t)MP * D, a.in[9] + D, mods + (size_t)NBI * NMOD + 3 * D, mods + (size_t)NBI * NMOD + 4 * D, H, PART, KS4, mods + (size_t)NBI * NMOD + 2 * D, X);
    SEAM(14);
    if (IN(15)) { EpiSwiGLU E{(bf16*)(R + R_ACT)}; run_gemm(lds, H, (const bf16*)(wb + W1_GU), 2 * DFF, D, E); }
    SEAM(15);
    if (IN(16)) { EpiRes E{X, X + (size_t)MP * D, X, mods + (size_t)NBI * NMOD + 5 * D}; run_gemm_res(lds, (const bf16*)(R + R_ACT), (const bf16*)(wb + W1_DN), DFF, E, PART, KS5); }
    SEAM(16);
    if (IN(17)) ph_final_norm(X, a.in[10], PART, KS5, mods + (size_t)NBI * NMOD + 5 * D);
#undef IN
#undef SEAM
}

#ifndef N_PHASES_RUN
#define N_PHASES_RUN 18
#endif
extern "C" void kernel_launch(void* const* d_in, const int* in_sizes, int n_in, void* d_out, int out_size, void* d_ws, size_t ws_size, hipStream_t stream) {
    static int grid = 0;
    if (grid == 0) {
        if (n_in != 23 || ws_size < WS_END) { fprintf(stderr, "kernel_launch: unexpected n_in %d / ws_size %zu (need %zu)\n", n_in, ws_size, (size_t)WS_END); grid = -1; return; }
        int dev = 0, cus = 0, per_cu = 0;
        hipGetDevice(&dev); hipDeviceGetAttribute(&cus, hipDeviceAttributeMultiprocessorCount, dev);
        if (hipFuncSetAttribute((const void*)mega_fwd, hipFuncAttributeMaxDynamicSharedMemorySize, LDS_BYTES + 256) != hipSuccess) { fprintf(stderr, "kernel_launch: hipFuncSetAttribute failed\n"); grid = -1; return; }
        if (hipOccupancyMaxActiveBlocksPerMultiprocessor(&per_cu, (const void*)mega_fwd, 512, LDS_BYTES + 256) != hipSuccess || per_cu < 1) per_cu = 1;
        (void)hipGetLastError();
        grid = cus * per_cu;
    }
    if (grid < 0) return;
    Args a{};
    for (int i = 0; i < 23; ++i) a.in[i] = (const float*)d_in[i];
    a.out = (float*)d_out; a.ws = (unsigned char*)d_ws; a.ph_lo = 0; a.ph_hi = N_PHASES_RUN;
    if (hipMemsetAsync((char*)d_ws + WS_BAR, 0, XCD_BAR_WORDS * 4, stream) != hipSuccess) { fprintf(stderr, "kernel_launch: memset failed\n"); return; }
    void* args[] = {&a};
    hipError_t e = hipLaunchCooperativeKernel((const void*)mega_fwd, dim3(grid), dim3(512), args, LDS_BYTES + 256, stream);
    if (e != hipSuccess) fprintf(stderr, "kernel_launch: cooperative launch failed: %s (grid %d)\n", hipGetErrorString(e), grid);
}
```

```cpp
#include <hip/hip_runtime.h>
#include <hip/hip_cooperative_groups.h>
#include <cstdio>
#include <cstdint>
namespace cg = cooperative_groups;
namespace pg8 {
#define PG8_LAS __attribute__((address_space(3)))
typedef unsigned short bf16_t;
typedef short bf16x8 __attribute__((ext_vector_type(8)));
typedef float f32x4 __attribute__((ext_vector_type(4)));
typedef unsigned u32x4 __attribute__((ext_vector_type(4)));
constexpr int BM = 256, BK = 64, HALF = 128, HTB = HALF * BK * 2  , STAGE_BYTES = 8 * HTB, NXCD = 8, WGM = 8;

__host__ __device__ __forceinline__ int lds_byte(int r, int c) { const int st = (r >> 4) * 2 + (c >> 5), rr = r & 15, cc = c & 31, ob = rr * 64 + cc * 2; return st * 1024 + (ob ^ (((ob >> 9) & 1) << 5)); }
__host__ __device__ __forceinline__ void stage_rc(int b, int& R, int& C) { const int st = b / 1024, sb = b % 1024, swz = sb ^ (((sb >> 9) & 1) << 5); R = (st >> 1) * 16 + swz / 64; C = (st & 1) * 32 + (swz % 64) / 2; }
__host__ __device__ __forceinline__ int perm32(int rho) { const int n = rho >> 4, i = rho & 15; return 8 * (i >> 2) + 4 * n + (i & 3); }

struct Unit { int pm, pn, k0; };
struct Gemm { const bf16_t* A; const bf16_t* Bt; int M, N, K, KL; };

struct StaticOrder {
    int nM, nN, nwg, G, c;
    __host__ __device__ void init(int M, int N, int G_, int c_) { nM = M / BM; nN = N / BM; nwg = nM * nN; G = G_; c = c_; }
    __host__ __device__ bool next(int i, Unit& u) const {
        const long L = (long)i * G + c; if (L >= nwg) return false;
        int wgid = (int)L; { const int q = nwg / NXCD, r = nwg % NXCD, xcd = wgid % NXCD, off = wgid / NXCD; wgid = (xcd < r ? xcd * (q + 1) : r * (q + 1) + (xcd - r) * q) + off; }
        const int nig = WGM * nN, gid = wgid / nig, fm = gid * WGM, gsz = (nM - fm) < WGM ? (nM - fm) : WGM;
        u.pm = fm + ((wgid % nig) % gsz); u.pn = (wgid % nig) / gsz; u.k0 = 0; return true;
    }
    __device__ __forceinline__ void a_ready(const Unit&) const {}
    __device__ __forceinline__ void done(const Unit&) const {}
};

__device__ __forceinline__ unsigned cvt_pk_bf16(float lo, float hi) { unsigned r; asm volatile("v_cvt_pk_bf16_f32 %0, %1, %2" : "=v"(r) : "v"(lo), "v"(hi)); return r; }
typedef float f32x2 __attribute__((ext_vector_type(2)));
template <class Epi, class Sched, bool ALIGN_EPI = false, bool SP2 = false>
__device__ __forceinline__ void gemm_phase(PG8_LAS unsigned char* lds, const Gemm g, const Sched& S, const Epi& E) {
    const int tid = threadIdx.x, wid = __builtin_amdgcn_readfirstlane(tid >> 6), lane = tid & 63, wr = wid >> 2, wc = wid & 3, fr = lane & 15, fq = lane >> 4;
    const int K = g.K, nt = g.KL / BK;
    unsigned voffA[2], voffB[2];
#pragma unroll
    for (int i = 0; i < 2; ++i) { int R, C; stage_rc(tid * 16 + i * 8192, R, C); const int Rb = Epi::PERM ? ((R & ~31) + perm32(R & 31)) : R;
        voffA[i] = (unsigned)(R * K + C) * 2u; voffB[i] = (unsigned)(Rb * K + C) * 2u; }
    const size_t kstep = (size_t)(BK * 2);
    const size_t hstep = (size_t)HALF * K * 2;
    const size_t tstep = 2 * hstep;
    const unsigned ldsw = (unsigned)wid * 1024u;
    const int aoff = lds_byte(wr * 64 + fr, fq * 8), boff = lds_byte(wc * 32 + fr, fq * 8);
#define PG8_SA(b, h) (((b) * 2 + (h)) * HTB)
#define PG8_SB(b, h) ((4 + (b) * 2 + (h)) * HTB)
#define PG8_STAGE(bufoff, gbase, voff) do { _Pragma("unroll") for (int _i = 0; _i < 2; ++_i) \
        __builtin_amdgcn_global_load_lds((const unsigned*)((const char*)(gbase) + (voff)[_i]), (PG8_LAS unsigned*)(lds + (bufoff) + ldsw + _i * 8192), 16, 0, 0); } while (0)
#define PG8_LDA(dst, b, h) do { _Pragma("unroll") for (int m = 0; m < 4; ++m) _Pragma("unroll") for (int k = 0; k < 2; ++k) dst[m][k] = *(const PG8_LAS bf16x8*)(lds + PG8_SA(b, h) + aoff + m * 2048 + k * 1024); } while (0)
#define PG8_LDB(dst, b, h) do { _Pragma("unroll") for (int n = 0; n < 2; ++n) _Pragma("unroll") for (int k = 0; k < 2; ++k) dst[n][k] = *(const PG8_LAS bf16x8*)(lds + PG8_SB(b, h) + boff + n * 2048 + k * 1024); } while (0)
#define PG8_MMA(ai, bj, At, Bt) do { __builtin_amdgcn_s_setprio(1); _Pragma("unroll") for (int m = 0; m < 4; ++m) _Pragma("unroll") for (int n = 0; n < 2; ++n) _Pragma("unroll") for (int k = 0; k < 2; ++k) \
        acc[ai][bj][m][n] = __builtin_amdgcn_mfma_f32_16x16x32_bf16(Bt[n][k], At[m][k], acc[ai][bj][m][n], 0, 0, 0); __builtin_amdgcn_s_setprio(0); } while (0)
#define PG8_WAIT_V(n) asm volatile("s_waitcnt vmcnt(" #n ")" ::: "memory")
#define PG8_WAIT_L(n) asm volatile("s_waitcnt lgkmcnt(" #n ")" ::: "memory")
#define PG8_BAR __builtin_amdgcn_s_barrier()
#define PG8_SCHED __builtin_amdgcn_sched_barrier(0)
    Unit cur, nxt; int ui = 0;
    if (!S.next(0, cur)) return;
    f32x4 acc[2][2][4][2];
#pragma unroll
    for (int a = 0; a < 2; ++a)
#pragma unroll
        for (int b = 0; b < 2; ++b)
#pragma unroll
            for (int m = 0; m < 4; ++m)
#pragma unroll
                for (int n = 0; n < 2; ++n) acc[a][b][m][n] = (f32x4){0.f, 0.f, 0.f, 0.f};
    bf16x8 At[4][2], B0[2][2], B1[2][2];
    const char* cA = (const char*)g.A + (size_t)cur.pm * tstep + (size_t)cur.k0 * 2; const char* cB = (const char*)g.Bt + (size_t)cur.pn * tstep + (size_t)cur.k0 * 2;
    S.a_ready(cur);
    if constexpr (SP2) {
        PG8_STAGE(PG8_SB(0, 0), cB, voffB); PG8_STAGE(PG8_SB(0, 1), cB + hstep, voffB); PG8_STAGE(PG8_SA(0, 0), cA, voffA); PG8_STAGE(PG8_SA(0, 1), cA + hstep, voffA);
        if (wr == 1) PG8_BAR;
        PG8_WAIT_V(2); PG8_BAR;
        PG8_STAGE(PG8_SB(1, 0), cB + kstep, voffB); PG8_STAGE(PG8_SA(1, 0), cA + kstep, voffA); PG8_STAGE(PG8_SB(1, 1), cB + hstep + kstep, voffB);
        PG8_WAIT_V(6); PG8_BAR;
    } else {
        PG8_STAGE(PG8_SB(0, 0), cB, voffB); PG8_STAGE(PG8_SA(0, 0), cA, voffA); PG8_STAGE(PG8_SB(0, 1), cB + hstep, voffB); PG8_STAGE(PG8_SA(0, 1), cA + hstep, voffA);
        if (wr == 1) PG8_BAR;
        PG8_WAIT_V(4); PG8_BAR;
        PG8_STAGE(PG8_SB(1, 0), cB + kstep, voffB); PG8_STAGE(PG8_SA(1, 0), cA + kstep, voffA); PG8_STAGE(PG8_SB(1, 1), cB + hstep + kstep, voffB);
        PG8_WAIT_V(6); PG8_BAR;
    }
    for (;;) {
        const bool has_next = S.next(ui + 1, nxt);
        const char* nA = has_next ? (const char*)g.A + (size_t)nxt.pm * tstep + (size_t)nxt.k0 * 2 : cA; const char* nB = has_next ? (const char*)g.Bt + (size_t)nxt.pn * tstep + (size_t)nxt.k0 * 2 : cB;
        for (int t = 0; t < nt; t += 2) {
            const bool last = (t == nt - 2);
            const char* a1 = cA + (size_t)(t + 1) * kstep;
            const char* a2 = last ? nA : cA + (size_t)(t + 2) * kstep; const char* b2 = last ? nB : cB + (size_t)(t + 2) * kstep;
            const char* a3 = a2 + kstep; const char* b3 = b2 + kstep;
            if (last && has_next) S.a_ready(nxt);
            if constexpr (SP2) {
            PG8_LDB(B0, 0, 0); PG8_LDB(B1, 0, 1); PG8_SCHED; PG8_LDA(At, 0, 0); PG8_STAGE(PG8_SA(1, 1), a1 + hstep, voffA);
            PG8_WAIT_V(8); PG8_WAIT_L(0); PG8_BAR; PG8_MMA(0, 0, At, B0); PG8_MMA(0, 1, At, B1); PG8_BAR; PG8_SCHED;
            PG8_LDA(At, 0, 1); PG8_STAGE(PG8_SB(0, 0), b2, voffB); PG8_STAGE(PG8_SB(0, 1), b2 + hstep, voffB); PG8_STAGE(PG8_SA(0, 0), a2, voffA);
            PG8_WAIT_V(8); PG8_WAIT_L(0); PG8_BAR; PG8_MMA(1, 0, At, B0); PG8_MMA(1, 1, At, B1); PG8_BAR; PG8_SCHED;
            PG8_LDB(B0, 1, 0); PG8_LDB(B1, 1, 1); PG8_SCHED; PG8_LDA(At, 1, 0); PG8_STAGE(PG8_SA(0, 1), a2 + hstep, voffA);
            PG8_WAIT_V(8); PG8_WAIT_L(0); PG8_BAR; PG8_MMA(0, 0, At, B0); PG8_MMA(0, 1, At, B1); PG8_BAR; PG8_SCHED;
            PG8_LDA(At, 1, 1); PG8_STAGE(PG8_SB(1, 0), b3, voffB); PG8_STAGE(PG8_SB(1, 1), b3 + hstep, voffB); PG8_STAGE(PG8_SA(1, 0), a3, voffA);
            PG8_WAIT_V(8); PG8_WAIT_L(0); PG8_BAR; PG8_MMA(1, 0, At, B0); PG8_MMA(1, 1, At, B1); PG8_BAR; PG8_SCHED;
            } else {
            PG8_LDB(B0, 0, 0); PG8_SCHED; PG8_LDA(At, 0, 0); PG8_STAGE(PG8_SA(1, 1), a1 + hstep, voffA);
            PG8_WAIT_L(8); PG8_BAR; PG8_WAIT_L(0); PG8_MMA(0, 0, At, B0); PG8_BAR; PG8_SCHED;
            PG8_LDB(B1, 0, 1); PG8_STAGE(PG8_SB(0, 0), b2, voffB);
            PG8_BAR; PG8_WAIT_L(0); PG8_MMA(0, 1, At, B1); PG8_BAR;
            PG8_LDA(At, 0, 1); PG8_STAGE(PG8_SA(0, 0), a2, voffA);
            PG8_BAR; PG8_WAIT_L(0); PG8_MMA(1, 0, At, B0); PG8_BAR; PG8_SCHED;
            PG8_STAGE(PG8_SB(0, 1), b2 + hstep, voffB);
            PG8_WAIT_V(6); PG8_BAR; PG8_MMA(1, 1, At, B1); PG8_BAR;
            PG8_LDB(B0, 1, 0); PG8_SCHED; PG8_LDA(At, 1, 0); PG8_STAGE(PG8_SA(0, 1), a2 + hstep, voffA);
            PG8_WAIT_L(8); PG8_BAR; PG8_WAIT_L(0); PG8_MMA(0, 0, At, B0); PG8_BAR; PG8_SCHED;
            PG8_LDB(B1, 1, 1); PG8_STAGE(PG8_SB(1, 0), b3, voffB);
            PG8_BAR; PG8_WAIT_L(0); PG8_MMA(0, 1, At, B1); PG8_BAR;
            PG8_LDA(At, 1, 1); PG8_STAGE(PG8_SA(1, 0), a3, voffA);
            PG8_BAR; PG8_WAIT_L(0); PG8_MMA(1, 0, At, B0); PG8_BAR; PG8_SCHED;
            PG8_STAGE(PG8_SB(1, 1), b3 + hstep, voffB);
            PG8_WAIT_V(6); PG8_BAR; PG8_MMA(1, 1, At, B1); PG8_BAR;
            }
        }
        if constexpr (ALIGN_EPI) { if (wr == 0) PG8_BAR; }
        if constexpr (!Epi::AFTER_DRAIN) { E(acc, cur, wr, wc, fr, fq); S.done(cur); }
        if (!has_next) break;
#pragma unroll
        for (int a = 0; a < 2; ++a)
#pragma unroll
            for (int b = 0; b < 2; ++b)
#pragma unroll
                for (int m = 0; m < 4; ++m)
#pragma unroll
                    for (int n = 0; n < 2; ++n) acc[a][b][m][n] = (f32x4){0.f, 0.f, 0.f, 0.f};
        cur = nxt; cA = nA; cB = nB; ++ui;
        if constexpr (ALIGN_EPI) { if (wr == 1) PG8_BAR; }
    }
    PG8_WAIT_V(0);
    if constexpr (!ALIGN_EPI) { if (wr == 0) PG8_BAR; }
    PG8_BAR;
    if constexpr (Epi::AFTER_DRAIN) { E.fused(acc, cur, wr, wc, fr, fq, lds, wid, lane); S.done(cur); }
#undef PG8_SA
#undef PG8_SB
#undef PG8_STAGE
#undef PG8_LDA
#undef PG8_LDB
#undef PG8_MMA
#undef PG8_WAIT_V
#undef PG8_WAIT_L
#undef PG8_BAR
#undef PG8_SCHED
}
}
#define LAS __attribute__((address_space(3)))
typedef unsigned short bf16;
typedef float f32x4 __attribute__((ext_vector_type(4)));
typedef float f32x2 __attribute__((ext_vector_type(2)));
typedef unsigned u32x4 __attribute__((ext_vector_type(4)));
typedef unsigned u32x2 __attribute__((ext_vector_type(2)));
typedef short bf16x8 __attribute__((ext_vector_type(8)));
typedef short s16x4 __attribute__((ext_vector_type(4)));

constexpr int D = 2048, SEQ = 8192, MP = 16384, MS = 512, M = MP + MS, NBI = 18;
constexpr int AW = 1024, DFF = 5632, NQKVG = 12288, VW = 4096, NMOD = 12288;
constexpr float EPS = 1e-6f;
constexpr int LDS_BYTES = 147456;

constexpr size_t OUT_Y = 0, OUT_POOLP = 34603008, OUT_POOLS = 34633728, OUT_VS = 34879488, OUT_RETP = 35403776, OUT_RETS = 37500928;
constexpr size_t WS_BAR = 0;
constexpr size_t WS_MODS = 65536;
constexpr size_t WS_COS = 3u << 20, WS_SIN = WS_COS + 4194304;
constexpr size_t WS_WSA = WS_SIN + 4194304;
constexpr size_t WS_WSB = WS_WSA + 262144;
constexpr size_t WS_WPT = WS_WSB + 262144;
constexpr size_t WS_PP = WS_WPT + 524288;
constexpr size_t WS_PS = WS_PP + 16777216;
constexpr size_t WS_W = 32u << 20;
constexpr size_t W0_IN = 0, W0_OUT = W0_IN + (size_t)3072 * 2048 * 2, W0_GU = W0_OUT + (size_t)2048 * 2048 * 2, W0_DN = W0_GU + (size_t)11264 * 2048 * 2;
constexpr size_t W1_IN = 0, W1_OUT = W1_IN + (size_t)12288 * 2048 * 2, W1_GU = W1_OUT + (size_t)2048 * 4096 * 2, W1_DN = W1_GU + (size_t)11264 * 2048 * 2;
constexpr size_t W_BYTES = W1_DN + (size_t)2048 * 5632 * 2;
constexpr size_t WS_H = WS_W + W_BYTES;
constexpr size_t WS_R = WS_H + (size_t)M * 2048 * 2;
constexpr size_t R_U = 0, R_V = R_U + (size_t)M * 1024 * 2, R_XB = R_V + (size_t)M * 1024 * 2;
constexpr size_t R_ACT = 0;
constexpr size_t R_Q = 0, R_K = R_Q + (size_t)M * 2048 * 2, R_VV = R_K + (size_t)M * 2048 * 2, R_G = R_VV + (size_t)M * 4096 * 2, R_O = R_G + (size_t)M * 4096 * 2;
constexpr size_t WS_END = WS_R + R_O + (size_t)M * 4096 * 2;
static_assert(WS_PS + 262144 <= WS_W, "ws map");
static_assert(WS_END <= 850000000ull, "ws too large");

__device__ __forceinline__ float bf2f(unsigned h) { return __uint_as_float(h << 16); }
typedef __bf16 bf16x2_t __attribute__((ext_vector_type(2)));
__device__ __forceinline__ unsigned pk2(float lo, float hi) { const f32x2 v = {lo, hi}; return __builtin_bit_cast(unsigned, __builtin_convertvector(v, bf16x2_t)); }
__device__ __forceinline__ float silu_f(float x) { return x * __builtin_amdgcn_rcpf(1.0f + __expf(-x)); }
__device__ __forceinline__ float gelu_tanh_f(float x) { const float z = 0.7978845608028654f * (x + 0.044715f * x * x * x); return x * __builtin_amdgcn_rcpf(1.0f + __expf(-2.0f * z)); }
__device__ __forceinline__ float wave_sum(float v) {
#pragma unroll
    for (int o = 1; o < 64; o <<= 1) v += __shfl_xor(v, o);
    return v;
}
__device__ __forceinline__ void unpack8(const u32x4 w, float (&f)[8]) {
    f[0] = __uint_as_float(w.x << 16); f[1] = __uint_as_float(w.x & 0xffff0000u); f[2] = __uint_as_float(w.y << 16); f[3] = __uint_as_float(w.y & 0xffff0000u);
    f[4] = __uint_as_float(w.z << 16); f[5] = __uint_as_float(w.z & 0xffff0000u); f[6] = __uint_as_float(w.w << 16); f[7] = __uint_as_float(w.w & 0xffff0000u);
}
__device__ __forceinline__ u32x4 pack8(const float (&f)[8]) { u32x4 w; w.x = pk2(f[0], f[1]); w.y = pk2(f[2], f[3]); w.z = pk2(f[4], f[5]); w.w = pk2(f[6], f[7]); return w; }
__device__ __forceinline__ int row_bi(int row) { return row < MP ? (row >> 13) : 2 + ((row - MP) >> 5); }
__device__ __forceinline__ float head_log_g(int h) { return log1pf(-exp2f(-5.0f - (float)h)); }
#define MFMA16(a, b, c) __builtin_amdgcn_mfma_f32_16x16x32_bf16((a), (b), (c), 0, 0, 0)
__device__ __forceinline__ int hm_row(int r, int h) { return r < MP ? (((r >> 13) * 8 + h) << 13) + (r & 8191) : MP * 8 + ((((r - MP) >> 5) * 8 + h) << 5) + ((r - MP) & 31); }
struct EpiInAB {
    static constexpr bool PERM = true, AFTER_DRAIN = false;
    bf16* U; bf16* V; bf16* XB; float* poolP; float* poolS;
    __device__ __forceinline__ void operator()(const f32x4 (&acc)[2][2][4][2], const pg8::Unit& u, int wr, int wc, int fr, int fq) const {
        const int t = u.pn >> 2, colt = (u.pn & 3) * 256 + wc * 32 + 8 * fq;
        bf16* base = U + (size_t)t * ((size_t)M * 1024);
#pragma unroll
        for (int ai = 0; ai < 2; ++ai)
#pragma unroll
            for (int m = 0; m < 4; ++m) {
                const int row = u.pm * 256 + ai * 128 + wr * 64 + m * 16 + fr;
                bf16* rowp = base + (size_t)row * 1024 + colt;
                float* sp = nullptr;
                if (t == 2) {
                    if (row < MP) { const int pos = row & 8191; if (pos >= 8177) sp = poolP + ((size_t)(row >> 13) * 15 + (pos - 8177)) * 1024 + colt; }
                    else { const int i = (row - MP) & 31; if (i >= 17) sp = poolS + ((size_t)((row - MP) >> 5) * 15 + (i - 17)) * 1024 + colt; }
                }
#pragma unroll
                for (int bj = 0; bj < 2; ++bj) {
                    f32x4 v0 = acc[ai][bj][m][0], v1 = acc[ai][bj][m][1];
                    if (t < 2) {
#pragma unroll
                        for (int j = 0; j < 4; ++j) { v0[j] = gelu_tanh_f(v0[j]); v1[j] = gelu_tanh_f(v1[j]); }
                    }
                    u32x4 w; w.x = pk2(v0[0], v0[1]); w.y = pk2(v0[2], v0[3]); w.z = pk2(v1[0], v1[1]); w.w = pk2(v1[2], v1[3]);
                    *(u32x4*)(rowp + bj * 128) = w;
                    if (sp) { *(f32x4*)(sp + bj * 128) = v0; *(f32x4*)(sp + bj * 128 + 4) = v1; }
                }
            }
    }
};
struct EpiRes {
    static constexpr bool PERM = false, AFTER_DRAIN = false;
    const float* baseP; const float* baseS; float* out; const float* gate;
    __device__ __forceinline__ void operator()(const f32x4 (&acc)[2][2][4][2], const pg8::Unit& u, int wr, int wc, int fr, int fq) const {
        const int col0 = u.pn * 256 + wc * 32 + 4 * fq;
#pragma unroll
        for (int ai = 0; ai < 2; ++ai)
#pragma unroll
            for (int m = 0; m < 4; ++m) {
                const int row = u.pm * 256 + ai * 128 + wr * 64 + m * 16 + fr;
                const float* bp = row < MP ? baseP + (size_t)row * D : baseS + (size_t)(row - MP) * D;
                const float* gp = gate + (size_t)row_bi(row) * NMOD;
                float* op = out + (size_t)row * D;
#pragma unroll
                for (int bj = 0; bj < 2; ++bj)
#pragma unroll
                    for (int n = 0; n < 2; ++n) { const int c = col0 + bj * 128 + n * 16;
                        const f32x4 b = *(const f32x4*)(bp + c), g = *(const f32x4*)(gp + c);
                        *(f32x4*)(op + c) = b + g * acc[ai][bj][m][n]; }
                if (m & 1) asm volatile("" ::: "memory");
            }
    }
};
struct EpiSwiGLU {
    static constexpr bool PERM = true, AFTER_DRAIN = false;
    bf16* ACT;
    __device__ __forceinline__ void operator()(const f32x4 (&acc)[2][2][4][2], const pg8::Unit& u, int wr, int wc, int fr, int fq) const {
        const int col0 = u.pn * 128 + wc * 32 + 8 * fq;
#pragma unroll
        for (int ai = 0; ai < 2; ++ai)
#pragma unroll
            for (int m = 0; m < 4; ++m) {
                const int row = u.pm * 256 + ai * 128 + wr * 64 + m * 16 + fr;
                float o[8];
#pragma unroll
                for (int n = 0; n < 2; ++n)
#pragma unroll
                    for (int j = 0; j < 4; ++j) o[n * 4 + j] = silu_f(acc[ai][0][m][n][j]) * acc[ai][1][m][n][j];
                *(u32x4*)(ACT + (size_t)row * DFF + col0) = pack8(o);
            }
    }
};
struct EpiQKVG {
    static constexpr bool PERM = true, AFTER_DRAIN = false;
    bf16* Q; bf16* K; bf16* V; bf16* G; const float* COS; const float* SIN;
    __device__ __forceinline__ void operator()(const f32x4 (&acc)[2][2][4][2], const pg8::Unit& u, int wr, int wc, int fr, int fq) const {
        const int pn = u.pn;
        if (pn < 16) {
            const int h = pn & 7; const bool isk = pn >= 8; const float lg = head_log_g(h) * 1.4426950408889634f;
            bf16* base = Q + (isk ? (size_t)M * 2048 : (size_t)0) + wc * 32 + 8 * fq;
            const int ch = wc * 32 + 8 * fq;
#pragma unroll
            for (int ai = 0; ai < 2; ++ai)
#pragma unroll
                for (int m = 0; m < 4; ++m) {
                    const int row = u.pm * 256 + ai * 128 + wr * 64 + m * 16 + fr;
                    int pos, n, L;
                    if (row < MP) { pos = row & 8191; n = pos & 63; L = 64; } else { n = (row - MP) & 31; pos = 2048 + n; L = 32; }
                    const float sc = isk ? 0.0625f * exp2f(lg * (float)(L - 1 - n)) : exp2f(lg * (float)(n + 1));
                    const f32x4 c0 = *(const f32x4*)(COS + (size_t)pos * 128 + ch), c1 = *(const f32x4*)(COS + (size_t)pos * 128 + ch + 4);
                    const f32x4 s0 = *(const f32x4*)(SIN + (size_t)pos * 128 + ch), s1 = *(const f32x4*)(SIN + (size_t)pos * 128 + ch + 4);
                    float o1[8], o2[8];
#pragma unroll
                    for (int j = 0; j < 4; ++j) {
                        const float a0 = acc[ai][0][m][0][j], b0 = acc[ai][1][m][0][j], a1 = acc[ai][0][m][1][j], b1 = acc[ai][1][m][1][j];
                        o1[j] = (a0 * c0[j] - b0 * s0[j]) * sc; o2[j] = (a0 * s0[j] + b0 * c0[j]) * sc;
                        o1[4 + j] = (a1 * c1[j] - b1 * s1[j]) * sc; o2[4 + j] = (a1 * s1[j] + b1 * c1[j]) * sc;
                    }
                    const int hrow = hm_row(row, h);
                    if (isk) { const size_t hr = (size_t)hrow * 256; *(u32x4*)(base + hr) = pack8(o1); *(u32x4*)(base + hr + 128) = pack8(o2); }
                    else {
                        bf16* qt = Q + ((size_t)(hrow >> 4) * 8 + wc) * 512 + (fq * 16 + (hrow & 15)) * 8;
                        *(u32x4*)qt = pack8(o1); *(u32x4*)(qt + 4 * 512) = pack8(o2); }
                }
        } else {
            const bool isg = pn >= 32; const int hv = (pn - 16) >> 1;
            bf16* base = V + (isg ? (size_t)M * 4096 + (size_t)(pn - 32) * 256 : (size_t)((pn - 16) & 1) * 256) + wc * 32 + 8 * fq;
#pragma unroll
            for (int ai = 0; ai < 2; ++ai)
#pragma unroll
                for (int m = 0; m < 4; ++m) {
                    const int row = u.pm * 256 + ai * 128 + wr * 64 + m * 16 + fr;
#pragma unroll
                    for (int bj = 0; bj < 2; ++bj) {
                        float o[8];
#pragma unroll
                        for (int n = 0; n < 2; ++n)
#pragma unroll
                            for (int j = 0; j < 4; ++j) { const float x = acc[ai][bj][m][n][j]; o[n * 4 + j] = isg ? silu_f(x) : x; }
                        *(u32x4*)(base + (isg ? (size_t)row * VW : (size_t)hm_row(row, hv) * 512) + bj * 128) = pack8(o);
                    }
                }
        }
    }
};
struct SplitOrder {
    int nN, KS, KL, G, c;
    __device__ __forceinline__ bool next(int i, pg8::Unit& u) const { const int L = i * G + c; if (L >= 2 * nN * KS) return false; u.pm = 64 + (L & 1); const int r = L >> 1; u.pn = r % nN; u.k0 = (r / nN) * KL; return true; }
    __device__ __forceinline__ void a_ready(const pg8::Unit&) const {}
    __device__ __forceinline__ void done(const pg8::Unit&) const {}
};
struct EpiPartial {
    static constexpr bool PERM = false, AFTER_DRAIN = false;
    float* PART; int KL;
    __device__ __forceinline__ void operator()(const f32x4 (&acc)[2][2][4][2], const pg8::Unit& u, int wr, int wc, int fr, int fq) const {
        const int col0 = u.pn * 256 + wc * 32 + 4 * fq, ks = u.k0 / KL;
#pragma unroll
        for (int ai = 0; ai < 2; ++ai)
#pragma unroll
            for (int m = 0; m < 4; ++m) {
                const int r = (u.pm - 64) * 256 + ai * 128 + wr * 64 + m * 16 + fr;
                float* op = PART + ((size_t)ks * MS + r) * D;
#pragma unroll
                for (int bj = 0; bj < 2; ++bj)
#pragma unroll
                    for (int n = 0; n < 2; ++n) *(f32x4*)(op + col0 + bj * 128 + n * 16) = acc[ai][bj][m][n];
            }
    }
};
__device__ __forceinline__ void transpose_item(const float* W, int K, int N, bf16* WT, int k0, int n0, int drow0, LAS float* scr, int lane) {
    float wv[32];
#pragma unroll
    for (int i = 0; i < 32; ++i) { const int kk = 2 * i + (lane >> 5); wv[i] = W[(size_t)(k0 + kk) * N + n0 + (lane & 31)]; }
#pragma unroll
    for (int i = 0; i < 32; ++i) { const int kk = 2 * i + (lane >> 5); scr[kk * 33 + (lane & 31)] = wv[i]; }
    asm volatile("s_waitcnt lgkmcnt(0)" ::: "memory");
    const int c = lane & 7;
#pragma unroll
    for (int j = 0; j < 4; ++j) { const int n = (lane >> 3) + 8 * j; const LAS float* s = scr + (8 * c) * 33 + n;
        u32x4 o; o.x = pk2(s[0 * 33], s[1 * 33]); o.y = pk2(s[2 * 33], s[3 * 33]); o.z = pk2(s[4 * 33], s[5 * 33]); o.w = pk2(s[6 * 33], s[7 * 33]);
        *(u32x4*)(WT + (size_t)(drow0 + n) * K + k0 + 8 * c) = o; }
    asm volatile("s_waitcnt lgkmcnt(0)" ::: "memory");
}
__device__ __forceinline__ void convert_weight(const float* W, int K, int N, bf16* WT, int mode, LAS float* scr, int lane, int gw, int ngw) {
    const int nblk = N / 32, nitems = (K / 64) * nblk;
    for (int it = gw; it < nitems; it += ngw) {
        const int kb = it / nblk, nb = it % nblk, n0 = nb * 32;
        int drow0 = n0;
        if (mode == 1) { if (n0 < DFF) drow0 = (n0 >> 7) * 256 + (n0 & 127); else { const int j0 = n0 - DFF; drow0 = (j0 >> 7) * 256 + 128 + (j0 & 127); } }
        transpose_item(W, K, N, WT, kb * 64, n0, drow0, scr, lane);
    }
}

__device__ __forceinline__ void ph_prologue(const float* const* in, unsigned char* ws, LAS unsigned char* lds) {
    const int tid = threadIdx.x, lane = tid & 63, wave = tid >> 6, G = gridDim.x;
    const float* c_p = in[2]; const float* c_s = in[3]; const float* w_ada = in[6]; const float* b_ada = in[7];
    float* mods = (float*)(ws + WS_MODS);
    LAS float* sc = (LAS float*)lds;
    LAS float* red = (LAS float*)(lds + 73728);
    for (int it = blockIdx.x; it < 192; it += G) {
        const int l = it / 96, nb = it % 96;
        const float* W = w_ada + (size_t)l * D * NMOD;
        f32x4 acc[NBI];
#pragma unroll
        for (int b = 0; b < NBI; ++b) acc[b] = (f32x4){0.f, 0.f, 0.f, 0.f};
        const int hh = lane >> 5, c4 = lane & 31;
        for (int kh = 0; kh < 2; ++kh) {
            __syncthreads();
            for (int e = tid; e < NBI * 1024; e += 512) { const int bi = e >> 10, kk = e & 1023;
                const float cv = bi < 2 ? c_p[bi * D + kh * 1024 + kk] : c_s[(bi - 2) * D + kh * 1024 + kk]; sc[e] = cv / (1.0f + __expf(-cv)); }
            __syncthreads();
            const float* wp = W + (size_t)(kh * 1024 + wave * 128 + hh) * NMOD + nb * 128 + c4 * 4;
            for (int j0 = 0; j0 < 64; j0 += 16) {
                f32x4 wv[16];
#pragma unroll
                for (int j = 0; j < 16; ++j) wv[j] = __builtin_nontemporal_load((const f32x4*)(wp + (size_t)(2 * (j0 + j)) * NMOD));
#pragma unroll
                for (int j = 0; j < 16; ++j) { const int kk = wave * 128 + 2 * (j0 + j) + hh;
#pragma unroll
                    for (int b = 0; b < NBI; ++b) { const float s = sc[b * 1024 + kk]; acc[b] += s * wv[j]; } }
            }
        }
#pragma unroll
        for (int b = 0; b < NBI; ++b)
#pragma unroll
            for (int q = 0; q < 4; ++q) acc[b][q] += __shfl_xor(acc[b][q], 32);
        if (lane < 32) {
#pragma unroll
            for (int b = 0; b < NBI; ++b) *(LAS f32x4*)(red + (wave * NBI + b) * 128 + c4 * 4) = acc[b];
        }
        __syncthreads();
        for (int e = tid; e < NBI * 128; e += 512) { const int bi = e >> 7, cc = e & 127;
            float s = b_ada[l * NMOD + nb * 128 + cc];
#pragma unroll
            for (int w = 0; w < 8; ++w) s += red[(w * NBI + bi) * 128 + cc];
            mods[(size_t)(l * NBI + bi) * NMOD + nb * 128 + cc] = s; }
    }
    __syncthreads();
    {
        LAS float* scr = (LAS float*)(lds + wave * 16384);
        const int gw = blockIdx.x * 8 + wave, ngw = G * 8;
        unsigned char* wb = ws + WS_W;
        convert_weight(in[11], D, 3072, (bf16*)(wb + W0_IN), 0, scr, lane, gw, ngw);
        convert_weight(in[18], D, D, (bf16*)(wb + W0_OUT), 0, scr, lane, gw, ngw);
        convert_weight(in[21], D, 2 * DFF, (bf16*)(wb + W0_GU), 1, scr, lane, gw, ngw);
        convert_weight(in[22], DFF, D, (bf16*)(wb + W0_DN), 0, scr, lane, gw, ngw);
    }
    const int gt = blockIdx.x * 512 + tid, ngt = G * 512;
    { const float* w_s = in[14]; bf16* wsa = (bf16*)(ws + WS_WSA); bf16* wsb = (bf16*)(ws + WS_WSB);
      for (int e = gt; e < 8 * 128 * 128; e += ngt) { const int g = e >> 14, t = (e >> 7) & 127, s = e & 127;
          const float a = ((s >> 6) <= (t >> 6)) ? w_s[e] : 0.f;
          const float b = ((s >> 5) == (t >> 5)) ? w_s[(g * 128 + (t & 31)) * 128 + (s & 31)] : 0.f;
          wsa[e] = (bf16)(pk2(a, 0.f) & 0xffffu); wsb[e] = (bf16)(pk2(b, 0.f) & 0xffffu); } }
    { const float* w_pool = in[16]; bf16* wpt = (bf16*)(ws + WS_WPT);
      for (int e = gt; e < 4 * 256 * 256; e += ngt) { const int g = e >> 16, d = (e >> 8) & 255, c = e & 255;
          wpt[e] = (bf16)(pk2(w_pool[(g * 256 + c) * 256 + d], 0.f) & 0xffffu); } }
    { float* COS = (float*)(ws + WS_COS); float* SIN = (float*)(ws + WS_SIN);
      for (int e = gt; e < 8192 * 128; e += ngt) { const int pos = e >> 7, ch = e & 127;
          const float freq = powf(10000.0f, -(float)ch / 128.0f); const float ang = (float)pos * freq;
          COS[e] = cosf(ang); SIN[e] = sinf(ang); } }
}

__device__ __forceinline__ void ph_norm(const float* xP, const float* xS, const float* g, const float* shiftb, const float* scaleb, bf16* H,
                                        const float* part, int KS, const float* gate, float* Xout) {
    const int lane = threadIdx.x & 63, gw = blockIdx.x * 8 + (threadIdx.x >> 6), ngw = gridDim.x * 8;
    for (int row = gw; row < M; row += ngw) {
        const f32x4* xr = (const f32x4*)(row < MP ? xP + (size_t)row * D : xS + (size_t)(row - MP) * D) + lane;
        const int bi = row_bi(row);
        f32x4 v[8];
#pragma unroll
        for (int j = 0; j < 8; ++j) v[j] = xr[64 * j];
        if (part && row >= MP) {
            f32x4 sacc[8];
#pragma unroll
            for (int j = 0; j < 8; ++j) sacc[j] = (f32x4){0.f, 0.f, 0.f, 0.f};
            for (int ks = 0; ks < KS; ++ks) { const f32x4* pp = (const f32x4*)(part + ((size_t)ks * MS + (row - MP)) * D) + lane;
#pragma unroll
                for (int j = 0; j < 8; ++j) sacc[j] += pp[64 * j]; }
            const f32x4* gt = (const f32x4*)(gate + (size_t)bi * NMOD) + lane; f32x4* xo = (f32x4*)(Xout + (size_t)row * D) + lane;
#pragma unroll
            for (int j = 0; j < 8; ++j) { v[j] += gt[64 * j] * sacc[j]; xo[64 * j] = v[j]; }
        }
        float s = 0.f;
#pragma unroll
        for (int j = 0; j < 8; ++j) s += (v[j].x * v[j].x + v[j].y * v[j].y) + (v[j].z * v[j].z + v[j].w * v[j].w);
        const float r = 1.0f / sqrtf(wave_sum(s) * (1.0f / D) + EPS);
        const f32x4* gp = (const f32x4*)g + lane; const f32x4* sh = (const f32x4*)(shiftb + (size_t)bi * NMOD) + lane; const f32x4* sc = (const f32x4*)(scaleb + (size_t)bi * NMOD) + lane;
        u32x2* o = (u32x2*)(H + (size_t)row * D) + lane;
#pragma unroll
        for (int j = 0; j < 8; ++j) { const f32x4 y = v[j] * r * gp[64 * j] * (1.0f + sc[64 * j]) + sh[64 * j]; u32x2 w; w.x = pk2(y.x, y.y); w.y = pk2(y.z, y.w); o[64 * j] = w; }
    }
}
__device__ __forceinline__ void ph_final_norm(float* X, const float* g, const float* part, int KS, const float* gate) {
    const int lane = threadIdx.x & 63, gw = blockIdx.x * 8 + (threadIdx.x >> 6), ngw = gridDim.x * 8;
    for (int row = gw; row < M; row += ngw) {
        f32x4* xr = (f32x4*)(X + (size_t)row * D) + lane;
        f32x4 v[8];
#pragma unroll
        for (int j = 0; j < 8; ++j) v[j] = xr[64 * j];
        if (row >= MP) {
            f32x4 sacc[8];
#pragma unroll
            for (int j = 0; j < 8; ++j) sacc[j] = (f32x4){0.f, 0.f, 0.f, 0.f};
            for (int ks = 0; ks < KS; ++ks) { const f32x4* pp = (const f32x4*)(part + ((size_t)ks * MS + (row - MP)) * D) + lane;
#pragma unroll
                for (int j = 0; j < 8; ++j) sacc[j] += pp[64 * j]; }
            const f32x4* gt = (const f32x4*)(gate + (size_t)row_bi(row) * NMOD) + lane;
#pragma unroll
            for (int j = 0; j < 8; ++j) v[j] += gt[64 * j] * sacc[j];
        }
        float s = 0.f;
#pragma unroll
        for (int j = 0; j < 8; ++j) s += (v[j].x * v[j].x + v[j].y * v[j].y) + (v[j].z * v[j].z + v[j].w * v[j].w);
        const float r = 1.0f / sqrtf(wave_sum(s) * (1.0f / D) + EPS);
        const f32x4* gp = (const f32x4*)g + lane;
#pragma unroll
        for (int j = 0; j < 8; ++j) xr[64 * j] = v[j] * r * gp[64 * j];
    }
}

__device__ __forceinline__ void ph_mixer(const float* const* in, unsigned char* ws, float* out, LAS unsigned char* lds) {
    const int tid = threadIdx.x, lane = tid & 63, wave = tid >> 6, fr = lane & 15, fq = lane >> 4;
    const bf16* U = (const bf16*)(ws + WS_R + R_U); const bf16* V = (const bf16*)(ws + WS_R + R_V); const bf16* XB = (const bf16*)(ws + WS_R + R_XB);
    bf16* CAT = (bf16*)(ws + WS_H);
    const float* ln_g = in[12]; const float* ln_b = in[13]; const float* b_s = in[15]; const float* pool_scale = in[17]; const float* hist = in[4];
    float* vs_out = out + OUT_VS;
    for (int unit = blockIdx.x; unit < 512 + 64; unit += gridDim.x) {
        const bool subu = unit >= 512; const int su = unit - 512;
        const int blk = subu ? 128 + (su >> 4) : unit >> 2, part = subu ? (su >> 2) & 3 : unit & 3, sub = su & 3;
        const int gi_lo = subu ? (part < 2 ? sub : sub >> 1) : 0, gi_hi = subu ? gi_lo + 1 : (part < 2 ? 4 : 2), dh_lo = subu ? (sub & 1) : 0, dh_hi = subu ? dh_lo + 1 : 2;
        const bool samp = blk >= 128;
        const int R0 = samp ? MP + (blk - 128) * 128 : blk * 128;
        if (part < 2) {
            LAS float* stat = (LAS float*)lds;
            LAS bf16* As = (LAS bf16*)(lds + 1024);
            LAS bf16* Bs = (LAS bf16*)(lds + 1024 + 34816);
            __syncthreads();
            for (int r = 0; r < 16; ++r) {
                const int t = wave * 16 + r;
                const u32x4* vp = (const u32x4*)(V + (size_t)(R0 + t) * 1024) + lane * 2;
                float f[16]; { float a[8], b[8]; unpack8(vp[0], a); unpack8(vp[1], b);
#pragma unroll
                    for (int j = 0; j < 8; ++j) { f[j] = a[j]; f[8 + j] = b[j]; } }
                float s = 0.f;
#pragma unroll
                for (int j = 0; j < 16; ++j) s += f[j];
                const float mean = wave_sum(s) * (1.0f / 1024.0f); float q = 0.f;
#pragma unroll
                for (int j = 0; j < 16; ++j) { const float d = f[j] - mean; q += d * d; }
                const float rstd = 1.0f / sqrtf(wave_sum(q) * (1.0f / 1024.0f) + EPS);
                if (lane == 0) { stat[2 * t] = mean; stat[2 * t + 1] = rstd; }
            }
            const bf16* wsrc = (const bf16*)(ws + (samp ? WS_WSB : WS_WSA));
            for (int gi = gi_lo; gi < gi_hi; ++gi) {
                const int g = part * 4 + gi;
                __syncthreads();
#pragma unroll
                for (int i = 0; i < 4; ++i) { const int e = tid + 512 * i, row = e >> 4, cc = e & 15;
                    *(LAS u32x4*)(As + row * 136 + cc * 8) = *(const u32x4*)(wsrc + (size_t)(g * 128 + row) * 128 + cc * 8); }
#pragma unroll
                for (int i = 0; i < 4; ++i) { const int e = tid + 512 * i, s = e >> 4, c8 = e & 15;
                    float f[8]; unpack8(*(const u32x4*)(V + (size_t)(R0 + s) * 1024 + g * 128 + c8 * 8), f);
                    const float mean = stat[2 * s], rstd = stat[2 * s + 1];
                    const f32x4 g0 = *(const f32x4*)(ln_g + g * 128 + c8 * 8), g1 = *(const f32x4*)(ln_g + g * 128 + c8 * 8 + 4);
                    const f32x4 b0 = *(const f32x4*)(ln_b + g * 128 + c8 * 8), b1 = *(const f32x4*)(ln_b + g * 128 + c8 * 8 + 4);
#pragma unroll
                    for (int j = 0; j < 4; ++j) { f[j] = (f[j] - mean) * rstd * g0[j] + b0[j]; f[4 + j] = (f[4 + j] - mean) * rstd * g1[j] + b1[j]; }
                    if (samp) { float* vo = vs_out + (size_t)(R0 - MP + s) * 1024 + g * 128 + c8 * 8;
                        *(f32x4*)vo = (f32x4){f[0], f[1], f[2], f[3]}; *(f32x4*)(vo + 4) = (f32x4){f[4], f[5], f[6], f[7]}; }
#pragma unroll
                    for (int j = 0; j < 8; j += 2) { const unsigned w = pk2(f[j], f[j + 1]); Bs[(c8 * 8 + j) * 136 + s] = (bf16)(w & 0xffffu); Bs[(c8 * 8 + j + 1) * 136 + s] = (bf16)(w >> 16); }
                }
                __syncthreads();
                f32x4 acc[8];
#pragma unroll
                for (int ct = 0; ct < 8; ++ct) acc[ct] = (f32x4){0.f, 0.f, 0.f, 0.f};
#pragma unroll
                for (int ks = 0; ks < 4; ++ks) {
                    const bf16x8 a = *(const LAS bf16x8*)(As + (wave * 16 + fr) * 136 + ks * 32 + fq * 8);
#pragma unroll
                    for (int ct = 0; ct < 8; ++ct) { const bf16x8 b = *(const LAS bf16x8*)(Bs + (ct * 16 + fr) * 136 + ks * 32 + fq * 8); acc[ct] = MFMA16(b, a, acc[ct]); }
                }
                {
                    LAS float* Ew = (LAS float*)(lds + 1024 + 2 * 34816) + wave * (16 * 132);
                    const int t = wave * 16 + fr; const float bsv = b_s[g * 128 + (samp ? (t & 31) : t)];
#pragma unroll
                    for (int ct = 0; ct < 8; ++ct) *(LAS f32x4*)(Ew + fr * 132 + ct * 16 + 4 * fq) = acc[ct] + bsv;
#pragma unroll
                    for (int it = 0; it < 4; ++it) { const int rr = it * 4 + (lane >> 4), c0 = (lane & 15) * 8, tt = wave * 16 + rr;
                        const f32x4 m0 = *(const LAS f32x4*)(Ew + rr * 132 + c0), m1 = *(const LAS f32x4*)(Ew + rr * 132 + c0 + 4);
                        float uf[8]; unpack8(*(const u32x4*)(U + (size_t)(R0 + tt) * 1024 + g * 128 + c0), uf);
                        float o[8] = {uf[0] * m0[0], uf[1] * m0[1], uf[2] * m0[2], uf[3] * m0[3], uf[4] * m1[0], uf[5] * m1[1], uf[6] * m1[2], uf[7] * m1[3]};
                        *(u32x4*)(CAT + (size_t)(R0 + tt) * D + g * 128 + c0) = pack8(o); }
                }
            }
        } else {
            LAS bf16* As = (LAS bf16*)lds;
            LAS bf16* Bs = (LAS bf16*)(lds + 67584);
            const bf16* WPT = (const bf16*)(ws + WS_WPT);
            for (int gi = gi_lo; gi < gi_hi; ++gi) {
                const int g = (part - 2) * 2 + gi, w = 2 << g;
                __syncthreads();
                {
                    const int tl = tid >> 5, co = tid & 31, t0 = tl * 8, cb = g * 256 + co * 8;
                    int sb = 0, i0 = 0, p0 = 0;
                    if (samp) { sb = (blk - 128) * 4 + (t0 >> 5); i0 = t0 & 31; } else { p0 = (R0 & 8191) + t0; }
                    auto ldrow = [&](int dt, float (&f)[8]) {
                        if (samp) { const int i = i0 + dt;
                            if (i >= 0) unpack8(*(const u32x4*)(XB + (size_t)(R0 + t0 + dt) * 1024 + cb), f);
                            else { const float* hp = hist + ((size_t)sb * 15 + (15 + i)) * 1024 + cb; const f32x4 a = *(const f32x4*)hp, b = *(const f32x4*)(hp + 4);
                                f[0] = a.x; f[1] = a.y; f[2] = a.z; f[3] = a.w; f[4] = b.x; f[5] = b.y; f[6] = b.z; f[7] = b.w; } }
                        else { if (p0 + dt >= 0) unpack8(*(const u32x4*)(XB + (size_t)(R0 + t0 + dt) * 1024 + cb), f);
                            else {
#pragma unroll
                                for (int j = 0; j < 8; ++j) f[j] = 0.f; } }
                    };
                    float S[8], x[8], y[8];
#pragma unroll
                    for (int j = 0; j < 8; ++j) S[j] = 0.f;
                    for (int j = 1; j < w; ++j) { ldrow(-j, x);
#pragma unroll
                        for (int q = 0; q < 8; ++q) S[q] += x[q]; }
                    for (int tt = 0; tt < 8; ++tt) {
                        ldrow(tt, x);
#pragma unroll
                        for (int q = 0; q < 8; ++q) S[q] += x[q];
                        const int pos = samp ? 2048 + i0 + tt : p0 + tt; const float inv = 1.0f / (float)(w < pos + 1 ? w : pos + 1);
                        float pv[8];
#pragma unroll
                        for (int q = 0; q < 8; ++q) pv[q] = S[q] * inv - x[q];
                        *(LAS u32x4*)(As + (t0 + tt) * 264 + co * 8) = pack8(pv);
                        ldrow(tt - w + 1, y);
#pragma unroll
                        for (int q = 0; q < 8; ++q) S[q] -= y[q];
                    }
                }
                for (int dh = dh_lo; dh < dh_hi; ++dh) {
                    __syncthreads();
#pragma unroll
                    for (int i = 0; i < 8; ++i) { const int e = tid + 512 * i, d = e >> 5, c8 = e & 31;
                        *(LAS u32x4*)(Bs + d * 264 + c8 * 8) = *(const u32x4*)(WPT + (size_t)(g * 256 + dh * 128 + d) * 256 + c8 * 8); }
                    __syncthreads();
                    f32x4 acc[8];
#pragma unroll
                    for (int ct = 0; ct < 8; ++ct) acc[ct] = (f32x4){0.f, 0.f, 0.f, 0.f};
#pragma unroll
                    for (int ks = 0; ks < 8; ++ks) {
                        const bf16x8 a = *(const LAS bf16x8*)(As + (wave * 16 + fr) * 264 + ks * 32 + fq * 8);
#pragma unroll
                        for (int ct = 0; ct < 8; ++ct) { const bf16x8 b = *(const LAS bf16x8*)(Bs + (ct * 16 + fr) * 264 + ks * 32 + fq * 8); acc[ct] = MFMA16(b, a, acc[ct]); }
                    }
                    __syncthreads();
                    {
                        LAS float* Ew = (LAS float*)(lds + 67584) + wave * (16 * 132);
#pragma unroll
                        for (int ct = 0; ct < 8; ++ct) *(LAS f32x4*)(Ew + fr * 132 + ct * 16 + 4 * fq) = acc[ct];
#pragma unroll
                        for (int it = 0; it < 4; ++it) { const int rr = it * 4 + (lane >> 4), c0 = (lane & 15) * 8, tt = wave * 16 + rr, dcol = g * 256 + dh * 128 + c0;
                            const f32x4 m0 = *(const LAS f32x4*)(Ew + rr * 132 + c0), m1 = *(const LAS f32x4*)(Ew + rr * 132 + c0 + 4);
                            const f32x4 p0 = *(const f32x4*)(pool_scale + dcol), p1 = *(const f32x4*)(pool_scale + dcol + 4);
                            float o[8] = {m0[0] * p0[0], m0[1] * p0[1], m0[2] * p0[2], m0[3] * p0[3], m1[0] * p1[0], m1[1] * p1[1], m1[2] * p1[2], m1[3] * p1[3]};
                            *(u32x4*)(CAT + (size_t)(R0 + tt) * D + 1024 + dcol) = pack8(o); }
                    }
                }
            }
        }
    }
}
template <int L> __device__ __forceinline__ void scores_unit(const bf16* Q, const bf16* K, bf16* P, int row0, int h, int lane) {
    constexpr int NT = L / 16; const int fr = lane & 15, fq = lane >> 4;
    const float sc = exp2f(-(float)L * head_log_g(h) * 1.4426950408889634f);
    for (int lt = 0; lt < NT; ++lt) {
        f32x4 acc[NT];
#pragma unroll
        for (int mt = 0; mt < NT; ++mt) acc[mt] = (f32x4){0.f, 0.f, 0.f, 0.f};
#pragma unroll
        for (int ks = 0; ks < 8; ++ks) {
            const bf16x8 a = *(const bf16x8*)(Q + (((size_t)(row0 >> 4) + lt) * 8 + ks) * 512 + lane * 8);
#pragma unroll
            for (int mt = 0; mt < NT; ++mt) { const bf16x8 b = *(const bf16x8*)(K + (size_t)(row0 + mt * 16 + fr) * 256 + ks * 32 + fq * 8); acc[mt] = MFMA16(b, a, acc[mt]); }
        }
        const int l = lt * 16 + fr;
#pragma unroll
        for (int mt = 0; mt < NT; ++mt) { const int m0 = mt * 16 + 4 * fq; float v[4];
#pragma unroll
            for (int r = 0; r < 4; ++r) v[r] = (l >= m0 + r) ? acc[mt][r] * sc : 0.f;
            u32x2 o; o.x = pk2(v[0], v[1]); o.y = pk2(v[2], v[3]);
            if (L == 64) *(u32x2*)(P + ((lt * 2 + (mt >> 1)) * 64 + ((mt & 1) * 2 + (fq >> 1)) * 16 + fr) * 8 + (fq & 1) * 4) = o;
            else *(u32x2*)(P + l * L + m0) = o; }
    }
}
__device__ __forceinline__ void ph_scores(unsigned char* ws) {
    const int lane = threadIdx.x & 63, gw = blockIdx.x * 8 + (threadIdx.x >> 6), ngw = gridDim.x * 8;
    const bf16* Q = (const bf16*)(ws + WS_R + R_Q); const bf16* K = (const bf16*)(ws + WS_R + R_K);
    for (int unit = gw; unit < 2048 + 128; unit += ngw) {
        if (unit < 2048) scores_unit<64>(Q, K, (bf16*)(ws + WS_PP) + (size_t)unit * 4096, hm_row((unit >> 3) * 64, unit & 7), unit & 7, lane);
        else { const int su = unit - 2048; scores_unit<32>(Q, K, (bf16*)(ws + WS_PS) + (size_t)su * 1024, hm_row(MP + (su >> 3) * 32, su & 7), su & 7, lane); }
    }
}

constexpr int RQP = 272, RVP = 80, RPP = 72;
constexpr int R_QS = 0, R_KS = R_QS + 64 * RQP * 2, R_VS = R_KS + 64 * RQP * 2, R_PS = R_VS + 64 * RVP * 2, R_ST = R_PS + 64 * RPP * 2, R_LDS_END = R_ST + 64 * RQP * 2;
static_assert(R_LDS_END <= 131072, "retention LDS");
__device__ __forceinline__ bf16x8 tr_frag(const LAS bf16* base, int pitch) {
    const s16x4 lo = __builtin_amdgcn_ds_read_tr16_b64_v4i16((LAS s16x4*)(base)), hi = __builtin_amdgcn_ds_read_tr16_b64_v4i16((LAS s16x4*)(base + 4 * pitch));
    return (bf16x8){lo[0], lo[1], lo[2], lo[3], hi[0], hi[1], hi[2], hi[3]};
}
template <int L> __device__ __forceinline__ void ret_unit(const bf16* Qd, const bf16* Kd, const bf16* Vv, const bf16* P, size_t pstride, bf16* O, int row0, int nchunks, int h, int e0,
                                                         const float* S0, float* Sout, LAS unsigned char* lds) {
    const int tid = threadIdx.x, lane = tid & 63, wave = tid >> 6, fr = lane & 15, fq = lane >> 4, tq = (lane & 15) >> 2, tp = lane & 3;
    LAS bf16* Qs = (LAS bf16*)(lds + R_QS); LAS bf16* Ks = (LAS bf16*)(lds + R_KS); LAS bf16* Vs = (LAS bf16*)(lds + R_VS); LAS bf16* Ps = (LAS bf16*)(lds + R_PS); LAS bf16* ST = (LAS bf16*)(lds + R_ST);
    constexpr int NQ = L / 16, TPW = L / 32, NKS = L / 32;
    constexpr bool VALL = (L == 64);
    const float gL = exp2f((float)L * head_log_g(h) * 1.4426950408889634f);
    f32x4 S[2][4];
#pragma unroll
    for (int dti = 0; dti < 2; ++dti)
#pragma unroll
        for (int et = 0; et < 4; ++et)
#pragma unroll
            for (int r = 0; r < 4; ++r) S[dti][et][r] = S0 ? S0[(size_t)((2 * wave + dti) * 16 + 4 * fq + r) * 512 + e0 + et * 16 + fr] : 0.f;
    u32x4 rq[NQ], rk[NQ], rv, rp;
    rv = (u32x4){0u, 0u, 0u, 0u}; rp = rv;
    const bool vact = VALL || tid < 8 * L, pact = tid < L * (L / 8);
#define RET_LOAD(c) do { const size_t rb = (size_t)row0 + (size_t)(c) * L; \
        _Pragma("unroll") for (int i = 0; i < NQ; ++i) { const int e = tid + 512 * i, r = e >> 5, pc = e & 31; \
            rq[i] = *(const u32x4*)(Qd + rb * 256 + (size_t)e * 8); rk[i] = *(const u32x4*)(Kd + (rb + r) * 256 + pc * 8); } \
        if (vact) rv = *(const u32x4*)(Vv + (rb + (tid >> 3)) * 512 + e0 + (tid & 7) * 8); \
        if (pact) rp = *(const u32x4*)(P + (size_t)(c) * pstride + (size_t)(tid / (L / 8)) * L + (tid % (L / 8)) * 8); } while (0)
    RET_LOAD(0);
    for (int c = 0; c < nchunks; ++c) {
        __syncthreads();
#pragma unroll
        for (int i = 0; i < NQ; ++i) { const int e = tid + 512 * i, r = e >> 5, pc = e & 31; *(LAS u32x4*)(Qs + ((e >> 9) * 16 + (e & 15)) * RQP + ((e >> 6) & 7) * 32 + ((e >> 4) & 3) * 8) = rq[i]; *(LAS u32x4*)(Ks + r * RQP + pc * 8) = rk[i]; }
        if (vact) *(LAS u32x4*)(Vs + (tid >> 3) * RVP + (tid & 7) * 8) = rv;
        if (pact) *(LAS u32x4*)(Ps + (tid / (L / 8)) * RPP + (tid % (L / 8)) * 8) = rp;
#pragma unroll
        for (int dti = 0; dti < 2; ++dti)
#pragma unroll
            for (int et = 0; et < 4; ++et) { u32x2 w; w.x = pk2(S[dti][et][0], S[dti][et][1]); w.y = pk2(S[dti][et][2], S[dti][et][3]);
                *(LAS u32x2*)(ST + (et * 16 + fr) * RQP + (2 * wave + dti) * 16 + 4 * fq) = w; }
        __syncthreads();
        if (c + 1 < nchunks) RET_LOAD(c + 1);
#pragma unroll
        for (int i = 0; i < TPW; ++i) {
            const int t = wave * TPW + i, lt = t >> 2, et = t & 3;
            f32x4 o = (f32x4){0.f, 0.f, 0.f, 0.f};
#pragma unroll
            for (int ks = 0; ks < 8; ++ks) { const bf16x8 a = *(const LAS bf16x8*)(Qs + (lt * 16 + fr) * RQP + ks * 32 + fq * 8), b = *(const LAS bf16x8*)(ST + (et * 16 + fr) * RQP + ks * 32 + fq * 8); o = MFMA16(b, a, o); }
#pragma unroll
            for (int ks = 0; ks < NKS; ++ks) { const bf16x8 a = *(const LAS bf16x8*)(Ps + (lt * 16 + fr) * RPP + ks * 32 + fq * 8), b = tr_frag(Vs + (ks * 32 + 8 * fq + tq) * RVP + et * 16 + 4 * tp, RVP); o = MFMA16(b, a, o); }
            u32x2 w; w.x = pk2(o[0], o[1]); w.y = pk2(o[2], o[3]);
            *(u32x2*)(O + ((size_t)row0 + (size_t)c * L + lt * 16 + fr) * 512 + e0 + et * 16 + 4 * fq) = w;
        }
#pragma unroll
        for (int dti = 0; dti < 2; ++dti)
#pragma unroll
            for (int et = 0; et < 4; ++et) S[dti][et] = S[dti][et] * gL;
#pragma unroll
        for (int ks = 0; ks < NKS; ++ks) {
            bf16x8 bv[4];
#pragma unroll
            for (int et = 0; et < 4; ++et) bv[et] = tr_frag(Vs + (ks * 32 + 8 * fq + tq) * RVP + et * 16 + 4 * tp, RVP);
#pragma unroll
            for (int dti = 0; dti < 2; ++dti) { const bf16x8 ak = tr_frag(Ks + (ks * 32 + 8 * fq + tq) * RQP + (2 * wave + dti) * 16 + 4 * tp, RQP);
#pragma unroll
                for (int et = 0; et < 4; ++et) S[dti][et] = MFMA16(ak, bv[et], S[dti][et]); }
        }
    }
#undef RET_LOAD
#pragma unroll
    for (int dti = 0; dti < 2; ++dti)
#pragma unroll
        for (int et = 0; et < 4; ++et)
#pragma unroll
            for (int r = 0; r < 4; ++r) Sout[(size_t)((2 * wave + dti) * 16 + 4 * fq + r) * 512 + e0 + et * 16 + fr] = S[dti][et][r];
}

constexpr int P_KB = 0, P_VB = 2 * 64 * RQP * 2, P_VP = 48, P_ST = P_VB + 2 * 64 * P_VP * 2, P_END = P_ST + 2 * 32 * RQP * 2;
static_assert(P_END <= 131072, "prompt retention LDS");
template <int VAR> __device__ __forceinline__ void ret_prompt(const bf16* Qd, const bf16* Kd, const bf16* Vv, const bf16* P, bf16* O, int row0, int h, int e0, float* Sout, LAS unsigned char* lds) {
    const int tid = threadIdx.x, lane = tid & 63, wave = tid >> 6, fr = lane & 15, fq = lane >> 4, tq = (lane & 15) >> 2, tp = lane & 3;
    constexpr int NCH = 128;
    const float gL = exp2f(64.0f * head_log_g(h) * 1.4426950408889634f);
    const int lt = wave >> 1, et_o = wave & 1;
    f32x4 S[2][2], ocar = (f32x4){0.f, 0.f, 0.f, 0.f};
#pragma unroll
    for (int a = 0; a < 2; ++a)
#pragma unroll
        for (int b = 0; b < 2; ++b) S[a][b] = (f32x4){0.f, 0.f, 0.f, 0.f};
    u32x4 rkA[4], rkB[4], rvA, rvB; rvA = (u32x4){0u, 0u, 0u, 0u}; rvB = rvA;
    bf16x8 qA[4], qB[4], pA[1], pB[1];
    const char* kbase = (const char*)(Kd + (size_t)row0 * 256); const char* vbase = (const char*)(Vv + (size_t)row0 * 512 + e0);
    const char* qbase = (const char*)(Qd + (size_t)row0 * 256); const char* pbase = (const char*)P; char* obase = (char*)(O + (size_t)row0 * 512 + e0);
    unsigned koff[4];
#pragma unroll
    for (int i = 0; i < 4; ++i) { const int e = tid + 512 * i; koff[i] = (unsigned)(e * 16); }
    const unsigned voff = (unsigned)((((tid & 255) >> 2) * 512 + (tid & 3) * 8) * 2), qoff = (unsigned)(((lt * 8 + et_o * 4) * 512 + lane * 8) * 2), poff = (unsigned)(((lt * 2 + et_o) * 512 + lane * 8) * 2);
    const unsigned ooff = (unsigned)(((lt * 16 + fr) * 512 + et_o * 16 + 4 * fq) * 2);
    unsigned klds[4];
#pragma unroll
    for (int i = 0; i < 4; ++i) { const int e = tid + 512 * i; klds[i] = (unsigned)(P_KB + ((e >> 5) * RQP + (e & 31) * 8) * 2); }
    const unsigned vlds = (unsigned)(P_VB + (((tid & 255) >> 2) * P_VP + (tid & 3) * 8) * 2);
    LAS unsigned char* xo = lds + P_END;
    const unsigned xwr = (unsigned)(((lt * 2 + et_o) * 64 + lane) * 16), xrd = (unsigned)(((lt * 2 + (et_o ^ 1)) * 64 + lane) * 16);
#define RP_LOADKV(rk, rv, c) do { const char* kc_ = kbase + (size_t)(c) * (64 * 256 * 2); const char* vc_ = vbase + (size_t)(c) * (64 * 512 * 2); \
        _Pragma("unroll") for (int i = 0; i < 4; ++i) rk[i] = *(const u32x4*)(kc_ + koff[i]); rv = *(const u32x4*)(vc_ + voff); } while (0)
#define RP_STOREKV(rk, rv, b) do { _Pragma("unroll") for (int i = 0; i < 4; ++i) *(LAS u32x4*)(lds + (b) * (64 * RQP * 2) + klds[i]) = rk[i]; \
        *(LAS u32x4*)(lds + (b) * (64 * P_VP * 2) + vlds) = rv; } while (0)
#define RP_LOADQP(dq, dp, c) do { const char* qc_ = qbase + (size_t)(c) * (64 * 256 * 2) + qoff; const char* pc_ = pbase + (size_t)(c) * (8 * 4096 * 2) + poff; \
        _Pragma("unroll") for (int ks = 0; ks < 4; ++ks) dq[ks] = *(const bf16x8*)(qc_ + ks * 1024); \
        dp[0] = *(const bf16x8*)(pc_); } while (0)
#define RP_STOREST(b) do { _Pragma("unroll") for (int dti = 0; dti < 2; ++dti) _Pragma("unroll") for (int et = 0; et < 2; ++et) { u32x2 w; w.x = pk2(S[dti][et][0], S[dti][et][1]); w.y = pk2(S[dti][et][2], S[dti][et][3]); \
        *(LAS u32x2*)(lds + P_ST + (b) * (32 * RQP * 2) + ((et * 16 + fr) * RQP + (2 * wave + dti) * 16 + 4 * fq) * 2) = w; } } while (0)
#define RP_BODY(c, cur, rkX, rvX, qX, pX) do { \
        asm volatile("s_waitcnt lgkmcnt(0)" ::: "memory"); __builtin_amdgcn_s_barrier(); asm volatile("" ::: "memory"); \
        RP_STOREKV(rkX, rvX, (cur) ^ 1); \
        if (VAR != 2) { const int ck = (c) + 3 < NCH ? (c) + 3 : NCH - 1; RP_LOADKV(rkX, rvX, ck); } \
        const LAS bf16* Kc = (const LAS bf16*)(lds + P_KB + (cur) * (64 * RQP * 2)); const LAS bf16* Vc = (const LAS bf16*)(lds + P_VB + (cur) * (64 * P_VP * 2)); \
        const LAS bf16* STp = (const LAS bf16*)(lds + P_ST + ((cur) ^ 1) * (32 * RQP * 2)); \
        bf16x8 bv[2][2], sb[4]; \
        _Pragma("unroll") for (int ks = 0; ks < 2; ++ks) _Pragma("unroll") for (int et = 0; et < 2; ++et) bv[ks][et] = tr_frag(Vc + (ks * 32 + 8 * fq + tq) * P_VP + et * 16 + 4 * tp, P_VP); \
        _Pragma("unroll") for (int a = 0; a < 2; ++a) _Pragma("unroll") for (int b = 0; b < 2; ++b) S[a][b] = S[a][b] * gL; \
        _Pragma("unroll") for (int ks = 0; ks < 2; ++ks) { bf16x8 ak[2]; \
          _Pragma("unroll") for (int dti = 0; dti < 2; ++dti) ak[dti] = tr_frag(Kc + (ks * 32 + 8 * fq + tq) * RQP + (2 * wave + dti) * 16 + 4 * tp, RQP); \
          _Pragma("unroll") for (int dti = 0; dti < 2; ++dti) _Pragma("unroll") for (int et = 0; et < 2; ++et) S[dti][et] = MFMA16(ak[dti], bv[ks][et], S[dti][et]); } \
        RP_STOREST(cur); \
        {   \
          const f32x4 opart = *(const LAS f32x4*)(xo + ((cur) ^ 1) * 8192 + xrd); \
          { const f32x4 o = ocar + opart; u32x2 w; w.x = pk2(o[0], o[1]); w.y = pk2(o[2], o[3]);     \
            *(u32x2*)(obase + (size_t)((c) > 0 ? (c) - 1 : 0) * (64 * 512 * 2) + ooff) = w; } \
          f32x4 om = (f32x4){0.f, 0.f, 0.f, 0.f}, ot = om; \
          _Pragma("unroll") for (int ks = 0; ks < 4; ++ks) { sb[ks] = *(const LAS bf16x8*)(STp + (et_o * 16 + fr) * RQP + (et_o * 4 + ks) * 32 + fq * 8); } \
          _Pragma("unroll") for (int ks = 0; ks < 4; ++ks) om = MFMA16(sb[ks], qX[ks], om); \
          _Pragma("unroll") for (int ks = 0; ks < 4; ++ks) { sb[ks] = *(const LAS bf16x8*)(STp + ((et_o ^ 1) * 16 + fr) * RQP + (et_o * 4 + ks) * 32 + fq * 8); } \
          { const bf16x8 bm = tr_frag(Vc + (et_o * 32 + 8 * fq + tq) * P_VP + et_o * 16 + 4 * tp, P_VP), bt = tr_frag(Vc + (et_o * 32 + 8 * fq + tq) * P_VP + (et_o ^ 1) * 16 + 4 * tp, P_VP); \
            om = MFMA16(bm, pX[0], om); ot = MFMA16(bt, pX[0], ot); } \
          _Pragma("unroll") for (int ks = 0; ks < 4; ++ks) ot = MFMA16(sb[ks], qX[ks], ot); \
          ocar = om; *(LAS f32x4*)(xo + (cur) * 8192 + xwr) = ot; } \
        if (VAR != 1) { const int cq = (c) + 2 < NCH ? (c) + 2 : NCH - 1; RP_LOADQP(qX, pX, cq); } \
        } while (0)
    __syncthreads();
    RP_LOADKV(rkA, rvA, 0); RP_STOREKV(rkA, rvA, 0); RP_STOREST(1);
    RP_LOADKV(rkA, rvA, 1); RP_LOADKV(rkB, rvB, 2); RP_LOADQP(qA, pA, 0); RP_LOADQP(qB, pB, 1);
#pragma nounroll
    for (int c = 0; c < NCH; c += 2) {
        RP_BODY(c, 0, rkA, rvA, qA, pA);
        __builtin_amdgcn_sched_barrier(0);
        RP_BODY(c + 1, 1, rkB, rvB, qB, pB);
        __builtin_amdgcn_sched_barrier(0);
    }
#undef RP_BODY
    asm volatile("s_waitcnt lgkmcnt(0)" ::: "memory"); __builtin_amdgcn_s_barrier(); asm volatile("" ::: "memory");
    { const f32x4 opart = *(const LAS f32x4*)(xo + ((NCH - 1) & 1) * 8192 + xrd); const f32x4 o = ocar + opart; u32x2 w; w.x = pk2(o[0], o[1]); w.y = pk2(o[2], o[3]);
      *(u32x2*)(obase + (size_t)(NCH - 1) * (64 * 512 * 2) + ooff) = w; }
#undef RP_LOADKV
#undef RP_STOREKV
#undef RP_LOADQP
#undef RP_STOREST
#pragma unroll
    for (int dti = 0; dti < 2; ++dti)
#pragma unroll
        for (int et = 0; et < 2; ++et)
#pragma unroll
            for (int r = 0; r < 4; ++r) Sout[(size_t)((2 * wave + dti) * 16 + 4 * fq + r) * 512 + e0 + et * 16 + fr] = S[dti][et][r];
}
__device__ __forceinline__ void ph_retention(const float* const* in, unsigned char* ws, float* out, LAS unsigned char* lds) {
    const bf16* Q = (const bf16*)(ws + WS_R + R_Q); const bf16* K = (const bf16*)(ws + WS_R + R_K); const bf16* V = (const bf16*)(ws + WS_R + R_VV); bf16* O = (bf16*)(ws + WS_R + R_O);
#if DUP_PHASE >= 200
    for (int task = blockIdx.x; task < 256; task += gridDim.x) {
        const int xcd = task & 7, idx = task >> 3, bh = xcd * 2 + (idx >> 4), sl = idx & 15, b = bh >> 3, h = bh & 7;
        ret_prompt<DUP_PHASE - 200>(Q, K, V, (const bf16*)(ws + WS_PP) + ((size_t)(b * 128) * 8 + h) * 4096, (bf16*)(ws + WS_H) - (size_t)bh * SEQ * 512, bh * SEQ, h, sl * 32, (float*)(ws + WS_H + (16u << 20)), lds);
    }
    __syncthreads();
#endif
    for (int task = blockIdx.x; task < 256; task += gridDim.x) {
        const int xcd = task & 7, idx = task >> 3, bh = xcd * 2 + (idx >> 4), sl = idx & 15, b = bh >> 3, h = bh & 7;
        ret_prompt<0>(Q, K, V, (const bf16*)(ws + WS_PP) + ((size_t)(b * 128) * 8 + h) * 4096, O, bh * SEQ, h, sl * 32, out + OUT_RETP + (size_t)bh * 256 * 512, lds);
    }
#if DUP_PHASE == 111
    for (int rep_ = 0; rep_ < 2; ++rep_)
#endif
    for (int task = blockIdx.x; task < 256; task += gridDim.x) {
        const int su = task >> 1, sb = su >> 3, h = su & 7;
        for (int sl = (task & 1) * 4; sl < (task & 1) * 4 + 4; ++sl)
            ret_unit<32>(Q, K, V, (const bf16*)(ws + WS_PS) + (size_t)su * 1024, 0, O, MP * 8 + su * 32, 1, h, sl * 64, in[5] + (size_t)su * 256 * 512, out + OUT_RETS + (size_t)su * 256 * 512, lds);
    }
}
__device__ __forceinline__ void ph_gate_norm(unsigned char* ws) {
    const int lane = threadIdx.x & 63, gw = blockIdx.x * 8 + (threadIdx.x >> 6), ngw = gridDim.x * 8;
    bf16* G = (bf16*)(ws + WS_R + R_G); const bf16* O = (const bf16*)(ws + WS_R + R_O);
    for (int row = gw; row < M; row += ngw) {
#pragma unroll
        for (int hh = 0; hh < 8; ++hh) {
            const size_t off = (size_t)row * VW + hh * 512 + lane * 8, ooff = (size_t)hm_row(row, hh) * 512 + lane * 8;
            float o[8], g[8]; unpack8(*(const u32x4*)(O + ooff), o); unpack8(*(const u32x4*)(G + off), g);
            float s = 0.f;
#pragma unroll
            for (int j = 0; j < 8; ++j) s += o[j] * o[j];
            const float r = 1.0f / sqrtf(wave_sum(s) * (1.0f / 512.0f) + EPS);
#pragma unroll
            for (int j = 0; j < 8; ++j) g[j] = g[j] * o[j] * r;
            *(u32x4*)(G + off) = pack8(g);
        }
    }
}

#define XB_TMO      128
#define XB_XCNT(j)  (256  + 64 * (j))
#define XB_XSUB(j)  (1280 + 64 * (j))
#define XB_XGEN(j)  (2304 + 64 * (j))
#define XB_TOP      3328
#define XB_TOPGEN   3392
#define XCD_BAR_WORDS 3456
#define XB_SPIN_CAP (1u << 18)

__device__ __forceinline__ unsigned xb_ld(unsigned* p)              { return __hip_atomic_load(p, __ATOMIC_RELAXED, __HIP_MEMORY_SCOPE_AGENT); }
__device__ __forceinline__ unsigned xb_add(unsigned* p, unsigned v) { return __hip_atomic_fetch_add(p, v, __ATOMIC_RELAXED, __HIP_MEMORY_SCOPE_AGENT); }
__device__ __forceinline__ unsigned xb_xcc_id() { return (unsigned)__builtin_amdgcn_s_getreg((3 << 11) | 20) & 0xFu; }
#define XB_SPIN(cond, bar) do { unsigned _sp = 0; while (cond) { __builtin_amdgcn_s_sleep(1); \
    if ((++_sp & 255u) == 0u) { if (xb_ld(&(bar)[XB_TMO])) break; if (_sp > XB_SPIN_CAP) { atomicAdd(&(bar)[XB_TMO], 1u); break; } } } } while (0)

struct XcdBarrier {
    unsigned* bar; unsigned x;
    volatile LAS unsigned* st;
};

__device__ __forceinline__ XcdBarrier xcd_barrier_post(unsigned* bar, volatile LAS unsigned* st) {
    XcdBarrier b; b.bar = bar; b.x = xb_xcc_id(); b.st = st;
    if (threadIdx.x == 0) (void)xb_add(&bar[XB_XCNT(b.x)], 1u);
    return b;
}
__device__ __forceinline__ void xcd_barrier_complete(unsigned* bar, unsigned x, unsigned& nloc, unsigned& nx) {
    const unsigned G = gridDim.x * gridDim.y * gridDim.z;
    unsigned sum, cnt, mine, sp = 0u;
    for (;;) {
        sum = 0u; cnt = 0u; mine = 0u;
#pragma unroll
        for (unsigned j = 0; j < 16; ++j) { const unsigned c = xb_ld(&bar[XB_XCNT(j)]); sum += c; cnt += (c > 0u) ? 1u : 0u; mine = (j == x) ? c : mine; }
        if (sum == G) break;
        __builtin_amdgcn_s_sleep(1);
        if ((++sp & 255u) == 0u) { if (xb_ld(&bar[XB_TMO])) break; if (sp > XB_SPIN_CAP) { atomicAdd(&bar[XB_TMO], 1u); break; } }
    }
    nloc = mine > 0u ? mine : 1u; nx = cnt > 0u ? cnt : 1u;
}

__device__ __forceinline__ void xcd_barrier(const XcdBarrier& b) {
    asm volatile("s_waitcnt vmcnt(0)" ::: "memory");
    __syncthreads();
    if (threadIdx.x == 0) {
        unsigned* bar = b.bar;
        __builtin_amdgcn_s_waitcnt(0);
        unsigned nloc = b.st[0], nx = b.st[1];
        if (nloc == 0u) { xcd_barrier_complete(bar, b.x, nloc, nx); b.st[0] = nloc; b.st[1] = nx; }
        const unsigned old = xb_add(&bar[XB_XSUB(b.x)], 1u);
        const unsigned gen = old / nloc;
        if (old + 1u == (gen + 1u) * nloc) {
            __builtin_amdgcn_fence(__ATOMIC_RELEASE, "agent");
            asm volatile("s_waitcnt vmcnt(0)" ::: "memory");
            const unsigned og = xb_add(&bar[XB_TOP], 1u);
            const unsigned tg = og / nx;
            if (og + 1u == (tg + 1u) * nx) xb_add(&bar[XB_TOPGEN], 1u);
            else XB_SPIN(xb_ld(&bar[XB_TOPGEN]) == tg, bar);
            __builtin_amdgcn_fence(__ATOMIC_ACQUIRE, "agent");
            xb_add(&bar[XB_XGEN(b.x)], 1u);
            asm volatile("s_waitcnt vmcnt(0)" ::: "memory");
        } else {
            XB_SPIN(xb_ld(&bar[XB_XGEN(b.x)]) == gen, bar);
            __builtin_amdgcn_fence(__ATOMIC_ACQUIRE, "agent");
            asm volatile("s_waitcnt vmcnt(0)" ::: "memory");
        }
    }
    __syncthreads();
}

struct Args { const float* in[23]; float* out; unsigned char* ws; int ph_lo, ph_hi; };
static_assert(sizeof(Args) == 23 * 8 + 8 + 8 + 8, "Args has no padding");

template <class Epi> __device__ __forceinline__ void run_gemm(LAS unsigned char* lds, const bf16* A, const bf16* Bt, int N, int K, const Epi& E) {
    pg8::Gemm g{A, Bt, M, N, K, K}; pg8::StaticOrder S; S.init(M, N, (int)gridDim.x, (int)blockIdx.x);
    pg8::gemm_phase<Epi, pg8::StaticOrder, true, true>(lds, g, S, E);
}
__device__ __forceinline__ void run_gemm_res(LAS unsigned char* lds, const bf16* A, const bf16* Bt, int K, const EpiRes& E, float* PART, int KS) {
    { pg8::Gemm g{A, Bt, MP, D, K, K}; pg8::StaticOrder S; S.init(MP, D, (int)gridDim.x, (int)blockIdx.x);
      pg8::gemm_phase<EpiRes, pg8::StaticOrder, true, true>(lds, g, S, E); }
    { const int KL = K / KS; pg8::Gemm g{A, Bt, M, D, K, KL}; SplitOrder S{D / 256, KS, KL, (int)gridDim.x, (int)blockIdx.x}; EpiPartial EP{PART, KL};
      pg8::gemm_phase<EpiPartial, SplitOrder, true, true>(lds, g, S, EP); }
}

__global__ void __launch_bounds__(512, 2) mega_fwd(Args a) {
    extern __shared__ __attribute__((aligned(16))) unsigned char lds_raw[];
    LAS unsigned char* lds = (LAS unsigned char*)lds_raw;
    cg::grid_group grid = cg::this_grid();
    unsigned char* ws = a.ws; float* out = a.out;
    const int lo = a.ph_lo, hi = a.ph_hi;
#define IN(k) (lo <= (k) && (k) < hi)
#ifndef DUP_PHASE
#define DUP_PHASE -1
#endif
#define SEAM(k) do { if (IN(k) && IN((k) + 1)) { if (lo < 0) { asm volatile("s_waitcnt vmcnt(0) lgkmcnt(0)" ::: "memory"); grid.sync(); } else xcd_barrier(xbar); } } while (0)
    volatile LAS unsigned* xst = (volatile LAS unsigned*)(lds + LDS_BYTES);
    if (threadIdx.x < 2) xst[threadIdx.x] = 0u;
    __syncthreads();
    XcdBarrier xbar = xcd_barrier_post((unsigned*)(ws + WS_BAR), xst);
    float* mods = (float*)(ws + WS_MODS);
    bf16* H = (bf16*)(ws + WS_H);
    unsigned char* wb = ws + WS_W; unsigned char* R = ws + WS_R;
    float* X = out + OUT_Y;
    float* PART = (float*)(R + R_O);
    constexpr int KS2 = 8, KS4 = 8, KS5 = 11;

    if (IN(0)) ph_prologue(a.in, ws, lds);
#if DUP_PHASE == 0
    __syncthreads();
    if (IN(0)) ph_prologue(a.in, ws, lds);
#endif
    SEAM(0);
    if (IN(1)) ph_norm(a.in[0], a.in[1], a.in[8], mods + 0 * D, mods + 1 * D, H, nullptr, 0, nullptr, nullptr);
#if DUP_PHASE == 1
    __syncthreads();
    if (IN(1)) ph_norm(a.in[0], a.in[1], a.in[8], mods + 0 * D, mods + 1 * D, H, nullptr, 0, nullptr, nullptr);
#endif
    SEAM(1);
    if (IN(2)) { EpiInAB E{(bf16*)(R + R_U), (bf16*)(R + R_V), (bf16*)(R + R_XB), out + OUT_POOLP, out + OUT_POOLS};
        run_gemm(lds, H, (const bf16*)(wb + W0_IN), 3072, D, E); }
#if DUP_PHASE == 2
    __syncthreads();
    if (IN(2)) { EpiInAB E{(bf16*)(R + R_U), (bf16*)(R + R_V), (bf16*)(R + R_XB), out + OUT_POOLP, out + OUT_POOLS};
        run_gemm(lds, H, (const bf16*)(wb + W0_IN), 3072, D, E); }
#endif
    SEAM(2);
    if (IN(3)) ph_mixer(a.in, ws, out, lds);
#if DUP_PHASE == 3
    __syncthreads();
    if (IN(3)) ph_mixer(a.in, ws, out, lds);
#endif
    SEAM(3);
    if (IN(4)) { EpiRes E{a.in[0], a.in[1], X, mods + 2 * D}; run_gemm_res(lds, H, (const bf16*)(wb + W0_OUT), D, E, PART, KS2); }
    SEAM(4);
    if (IN(5)) ph_norm(X, a.in[1], a.in[9], mods + 3 * D, mods + 4 * D, H, PART, KS2, mods + 2 * D, X);
    SEAM(5);
    if (IN(6)) { EpiSwiGLU E{(bf16*)(R + R_ACT)}; run_gemm(lds, H, (const bf16*)(wb + W0_GU), 2 * DFF, D, E); }
#if DUP_PHASE == 6
    __syncthreads();
    if (IN(6)) { EpiSwiGLU E{(bf16*)(R + R_ACT)}; run_gemm(lds, H, (const bf16*)(wb + W0_GU), 2 * DFF, D, E); }
#endif
    SEAM(6);
    if (IN(7)) { EpiRes E{X, X + (size_t)MP * D, X, mods + 5 * D}; run_gemm_res(lds, (const bf16*)(R + R_ACT), (const bf16*)(wb + W0_DN), DFF, E, PART, KS5); }
    SEAM(7);
    if (IN(8)) {
        ph_norm(X, X + (size_t)MP * D, a.in[8] + D, mods + (size_t)NBI * NMOD + 0 * D, mods + (size_t)NBI * NMOD + 1 * D, H, PART, KS5, mods + 5 * D, X);
        __syncthreads();
        const int lane = threadIdx.x & 63, wave = threadIdx.x >> 6; LAS float* scr = (LAS float*)(lds + wave * 16384);
        const int gw = blockIdx.x * 8 + wave, ngw = gridDim.x * 8;
        convert_weight(a.in[19], D, NQKVG, (bf16*)(wb + W1_IN), 0, scr, lane, gw, ngw);
        convert_weight(a.in[20], VW, D, (bf16*)(wb + W1_OUT), 0, scr, lane, gw, ngw);
        convert_weight(a.in[21] + (size_t)D * 2 * DFF, D, 2 * DFF, (bf16*)(wb + W1_GU), 1, scr, lane, gw, ngw);
        convert_weight(a.in[22] + (size_t)DFF * D, DFF, D, (bf16*)(wb + W1_DN), 0, scr, lane, gw, ngw);
    }
    SEAM(8);
    if (IN(9)) { EpiQKVG E{(bf16*)(R + R_Q), (bf16*)(R + R_K), (bf16*)(R + R_VV), (bf16*)(R + R_G), (const float*)(ws + WS_COS), (const float*)(ws + WS_SIN)};
        run_gemm(lds, H, (const bf16*)(wb + W1_IN), NQKVG, D, E); }
#if DUP_PHASE == 9
    __syncthreads();
    if (IN(9)) { EpiQKVG E{(bf16*)(R + R_Q), (bf16*)(R + R_K), (bf16*)(R + R_VV), (bf16*)(R + R_G), (const float*)(ws + WS_COS), (const float*)(ws + WS_SIN)};
        run_gemm(lds, H, (const bf16*)(wb + W1_IN), NQKVG, D, E); }
#endif
    SEAM(9);
    if (IN(10)) ph_scores(ws);
#if DUP_PHASE == 10
    __syncthreads();
    if (IN(10)) ph_scores(ws);
#endif
    SEAM(10);
    if (IN(11)) ph_retention(a.in, ws, out, lds);
#if DUP_PHASE == 11
    __syncthreads();
    if (IN(11)) ph_retention(a.in, ws, out, lds);
#endif
    SEAM(11);
    if (IN(12)) ph_gate_norm(ws);
    SEAM(12);
    if (IN(13)) { EpiRes E{X, X + (size_t)MP * D, X, mods + (size_t)NBI * NMOD + 2 * D}; run_gemm_res(lds, (const bf16*)(R + R_G), (const bf16*)(wb + W1_OUT), VW, E, PART, KS4); }
    SEAM(13);
    if (IN(14)) ph_norm(X, X + (size_t)MP * D, a.in[9] + D, mods + (size_t)NBI * NMOD + 3 * D, mods + (size_t)NBI * NMOD + 4 * D, H, PART, KS4, mods + (size_t)NBI * NMOD + 2 * D, X);
    SEAM(14);
    if (IN(15)) { EpiSwiGLU E{(bf16*)(R + R_ACT)}; run_gemm(lds, H, (const bf16*)(wb + W1_GU), 2 * DFF, D, E); }
    SEAM(15);
    if (IN(16)) { EpiRes E{X, X + (size_t)MP * D, X, mods + (size_t)NBI * NMOD + 5 * D}; run_gemm_res(lds, (const bf16*)(R + R_ACT), (const bf16*)(wb + W1_DN), DFF, E, PART, KS5); }
    SEAM(16);
    if (IN(17)) ph_final_norm(X, a.in[10], PART, KS5, mods + (size_t)NBI * NMOD + 5 * D);
#undef IN
#undef SEAM
}

#ifndef N_PHASES_RUN
#define N_PHASES_RUN 18
#endif
extern "C" void kernel_launch(void* const* d_in, const int* in_sizes, int n_in, void* d_out, int out_size, void* d_ws, size_t ws_size, hipStream_t stream) {
    static int grid = 0;
    if (grid == 0) {
        if (n_in != 23 || ws_size < WS_END) { fprintf(stderr, "kernel_launch: unexpected n_in %d / ws_size %zu (need %zu)\n", n_in, ws_size, (size_t)WS_END); grid = -1; return; }
        int dev = 0, cus = 0, per_cu = 0;
        hipGetDevice(&dev); hipDeviceGetAttribute(&cus, hipDeviceAttributeMultiprocessorCount, dev);
        if (hipFuncSetAttribute((const void*)mega_fwd, hipFuncAttributeMaxDynamicSharedMemorySize, LDS_BYTES + 256) != hipSuccess) { fprintf(stderr, "kernel_launch: hipFuncSetAttribute failed\n"); grid = -1; return; }
        if (hipOccupancyMaxActiveBlocksPerMultiprocessor(&per_cu, (const void*)mega_fwd, 512, LDS_BYTES + 256) != hipSuccess || per_cu < 1) per_cu = 1;
        (void)hipGetLastError();
        grid = cus * per_cu;
    }
    if (grid < 0) return;
    Args a{};
    for (int i = 0; i < 23; ++i) a.in[i] = (const float*)d_in[i];
    a.out = (float*)d_out; a.ws = (unsigned char*)d_ws; a.ph_lo = 0; a.ph_hi = N_PHASES_RUN;
    if (hipMemsetAsync((char*)d_ws + WS_BAR, 0, XCD_BAR_WORDS * 4, stream) != hipSuccess) { fprintf(stderr, "kernel_launch: memset failed\n"); return; }
    void* args[] = {&a};
    hipError_t e = hipLaunchCooperativeKernel((const void*)mega_fwd, dim3(grid), dim3(512), args, LDS_BYTES + 256, stream);
    if (e != hipSuccess) fprintf(stderr, "kernel_launch: cooperative launch failed: %s (grid %d)\n", hipGetErrorString(e), grid);
}
```

```cpp
#include <hip/hip_runtime.h>
#include <hip/hip_cooperative_groups.h>
#include <cstdio>
#include <cstdint>
namespace cg = cooperative_groups;
namespace pg8 {
#define PG8_LAS __attribute__((address_space(3)))
typedef unsigned short bf16_t;
typedef short bf16x8 __attribute__((ext_vector_type(8)));
typedef float f32x4 __attribute__((ext_vector_type(4)));
typedef unsigned u32x4 __attribute__((ext_vector_type(4)));
constexpr int BM = 256, BK = 64, HALF = 128, HTB = HALF * BK * 2  , STAGE_BYTES = 8 * HTB, NXCD = 8, WGM = 4;

__host__ __device__ __forceinline__ int lds_byte(int r, int c) { const int st = (r >> 4) * 2 + (c >> 5), rr = r & 15, cc = c & 31, ob = rr * 64 + cc * 2; return st * 1024 + (ob ^ (((ob >> 9) & 1) << 5)); }
__host__ __device__ __forceinline__ void stage_rc(int b, int& R, int& C) { const int st = b / 1024, sb = b % 1024, swz = sb ^ (((sb >> 9) & 1) << 5); R = (st >> 1) * 16 + swz / 64; C = (st & 1) * 32 + (swz % 64) / 2; }
__host__ __device__ __forceinline__ int perm32(int rho) { const int n = rho >> 4, i = rho & 15; return 8 * (i >> 2) + 4 * n + (i & 3); }

struct Unit { int pm, pn, k0; };
struct Gemm { const bf16_t* A; const bf16_t* Bt; int M, N, K, KL; };

struct StaticOrder {
    int nM, nN, nwg, G, c, wgm;
    __host__ __device__ void init(int M, int N, int G_, int c_, int wgm_ = WGM) { nM = M / BM; nN = N / BM; nwg = nM * nN; G = G_; c = c_; wgm = wgm_; }
    __host__ __device__ bool next(int i, Unit& u) const {
        const long L = (long)i * G + c; if (L >= nwg) return false;
        int wgid = (int)L; { const int q = nwg / NXCD, r = nwg % NXCD, xcd = wgid % NXCD, off = wgid / NXCD; wgid = (xcd < r ? xcd * (q + 1) : r * (q + 1) + (xcd - r) * q) + off; }
        const int nig = wgm * nN, gid = wgid / nig, fm = gid * wgm, gsz = (nM - fm) < wgm ? (nM - fm) : wgm;
        u.pm = fm + ((wgid % nig) % gsz); u.pn = (wgid % nig) / gsz; u.k0 = 0; return true;
    }
    __device__ __forceinline__ void a_ready(const Unit&) const {}
    __device__ __forceinline__ void done(const Unit&) const {}
};

__device__ __forceinline__ unsigned cvt_pk_bf16(float lo, float hi) { unsigned r; asm volatile("v_cvt_pk_bf16_f32 %0, %1, %2" : "=v"(r) : "v"(lo), "v"(hi)); return r; }
typedef float f32x2 __attribute__((ext_vector_type(2)));
template <class Epi, class Sched, bool ALIGN_EPI = false, bool SP2 = false>
__device__ __forceinline__ void gemm_phase(PG8_LAS unsigned char* lds, const Gemm g, const Sched& S, const Epi& E) {
    const int tid = threadIdx.x, wid = __builtin_amdgcn_readfirstlane(tid >> 6), lane = tid & 63, wr = wid >> 2, wc = wid & 3, fr = lane & 15, fq = lane >> 4;
    const int K = g.K, nt = g.KL / BK;
    unsigned voffA[2], voffB[2];
#pragma unroll
    for (int i = 0; i < 2; ++i) { int R, C; stage_rc(tid * 16 + i * 8192, R, C); const int Rb = Epi::PERM ? ((R & ~31) + perm32(R & 31)) : R;
        voffA[i] = (unsigned)(R * K + C) * 2u; voffB[i] = (unsigned)(Rb * K + C) * 2u; }
    const size_t kstep = (size_t)(BK * 2);
    const size_t hstep = (size_t)HALF * K * 2;
    const size_t tstep = 2 * hstep;
    const unsigned ldsw = (unsigned)wid * 1024u;
    const int aoff = lds_byte(wr * 64 + fr, fq * 8), boff = lds_byte(wc * 32 + fr, fq * 8);
#define PG8_SA(b, h) (((b) * 2 + (h)) * HTB)
#define PG8_SB(b, h) ((4 + (b) * 2 + (h)) * HTB)
#define PG8_STAGE(bufoff, gbase, voff) do { _Pragma("unroll") for (int _i = 0; _i < 2; ++_i) \
        __builtin_amdgcn_global_load_lds((const unsigned*)((const char*)(gbase) + (voff)[_i]), (PG8_LAS unsigned*)(lds + (bufoff) + ldsw + _i * 8192), 16, 0, 0); } while (0)
#define PG8_LDA(dst, b, h) do { _Pragma("unroll") for (int m = 0; m < 4; ++m) _Pragma("unroll") for (int k = 0; k < 2; ++k) dst[m][k] = *(const PG8_LAS bf16x8*)(lds + PG8_SA(b, h) + aoff + m * 2048 + k * 1024); } while (0)
#define PG8_LDB(dst, b, h) do { _Pragma("unroll") for (int n = 0; n < 2; ++n) _Pragma("unroll") for (int k = 0; k < 2; ++k) dst[n][k] = *(const PG8_LAS bf16x8*)(lds + PG8_SB(b, h) + boff + n * 2048 + k * 1024); } while (0)
#define PG8_MMA(ai, bj, At, Bt) do { __builtin_amdgcn_s_setprio(1); _Pragma("unroll") for (int m = 0; m < 4; ++m) _Pragma("unroll") for (int n = 0; n < 2; ++n) _Pragma("unroll") for (int k = 0; k < 2; ++k) \
        acc[ai][bj][m][n] = __builtin_amdgcn_mfma_f32_16x16x32_bf16(Bt[n][k], At[m][k], acc[ai][bj][m][n], 0, 0, 0); __builtin_amdgcn_s_setprio(0); } while (0)
#define PG8_WAIT_V(n) asm volatile("s_waitcnt vmcnt(" #n ")" ::: "memory")
#define PG8_WAIT_L(n) asm volatile("s_waitcnt lgkmcnt(" #n ")" ::: "memory")
#define PG8_BAR __builtin_amdgcn_s_barrier()
#define PG8_SCHED __builtin_amdgcn_sched_barrier(0)
    Unit cur, nxt; int ui = 0;
    if (!S.next(0, cur)) return;
    f32x4 acc[2][2][4][2];
#pragma unroll
    for (int a = 0; a < 2; ++a)
#pragma unroll
        for (int b = 0; b < 2; ++b)
#pragma unroll
            for (int m = 0; m < 4; ++m)
#pragma unroll
                for (int n = 0; n < 2; ++n) acc[a][b][m][n] = (f32x4){0.f, 0.f, 0.f, 0.f};
    bf16x8 At[4][2], B0[2][2], B1[2][2];
    const char* cA = (const char*)g.A + (size_t)cur.pm * tstep + (size_t)cur.k0 * 2; const char* cB = (const char*)g.Bt + (size_t)cur.pn * tstep + (size_t)cur.k0 * 2;
    S.a_ready(cur);
    if constexpr (SP2) {
        PG8_STAGE(PG8_SB(0, 0), cB, voffB); PG8_STAGE(PG8_SB(0, 1), cB + hstep, voffB); PG8_STAGE(PG8_SA(0, 0), cA, voffA); PG8_STAGE(PG8_SA(0, 1), cA + hstep, voffA);
        if (wr == 1) PG8_BAR;
        PG8_WAIT_V(2); PG8_BAR;
        PG8_STAGE(PG8_SB(1, 0), cB + kstep, voffB); PG8_STAGE(PG8_SA(1, 0), cA + kstep, voffA); PG8_STAGE(PG8_SB(1, 1), cB + hstep + kstep, voffB);
        PG8_WAIT_V(6); PG8_BAR;
    } else {
        PG8_STAGE(PG8_SB(0, 0), cB, voffB); PG8_STAGE(PG8_SA(0, 0), cA, voffA); PG8_STAGE(PG8_SB(0, 1), cB + hstep, voffB); PG8_STAGE(PG8_SA(0, 1), cA + hstep, voffA);
        if (wr == 1) PG8_BAR;
        PG8_WAIT_V(4); PG8_BAR;
        PG8_STAGE(PG8_SB(1, 0), cB + kstep, voffB); PG8_STAGE(PG8_SA(1, 0), cA + kstep, voffA); PG8_STAGE(PG8_SB(1, 1), cB + hstep + kstep, voffB);
        PG8_WAIT_V(6); PG8_BAR;
    }
    for (;;) {
        const bool has_next = S.next(ui + 1, nxt);
        const char* nA = has_next ? (const char*)g.A + (size_t)nxt.pm * tstep + (size_t)nxt.k0 * 2 : cA; const char* nB = has_next ? (const char*)g.Bt + (size_t)nxt.pn * tstep + (size_t)nxt.k0 * 2 : cB;
        for (int t = 0; t < nt; t += 2) {
            const bool last = (t == nt - 2);
            const char* a1 = cA + (size_t)(t + 1) * kstep;
            const char* a2 = last ? nA : cA + (size_t)(t + 2) * kstep; const char* b2 = last ? nB : cB + (size_t)(t + 2) * kstep;
            const char* a3 = a2 + kstep; const char* b3 = b2 + kstep;
            if (last && has_next) S.a_ready(nxt);
            if constexpr (SP2) {
            PG8_LDB(B0, 0, 0); PG8_LDB(B1, 0, 1); PG8_SCHED; PG8_LDA(At, 0, 0); PG8_STAGE(PG8_SA(1, 1), a1 + hstep, voffA);
            PG8_WAIT_V(8); PG8_WAIT_L(0); PG8_BAR; PG8_MMA(0, 0, At, B0); PG8_MMA(0, 1, At, B1); PG8_BAR; PG8_SCHED;
            PG8_LDA(At, 0, 1); PG8_STAGE(PG8_SB(0, 0), b2, voffB); PG8_STAGE(PG8_SB(0, 1), b2 + hstep, voffB); PG8_STAGE(PG8_SA(0, 0), a2, voffA);
            PG8_WAIT_V(8); PG8_WAIT_L(0); PG8_BAR; PG8_MMA(1, 0, At, B0); PG8_MMA(1, 1, At, B1); PG8_BAR; PG8_SCHED;
            PG8_LDB(B0, 1, 0); PG8_LDB(B1, 1, 1); PG8_SCHED; PG8_LDA(At, 1, 0); PG8_STAGE(PG8_SA(0, 1), a2 + hstep, voffA);
            PG8_WAIT_V(8); PG8_WAIT_L(0); PG8_BAR; PG8_MMA(0, 0, At, B0); PG8_MMA(0, 1, At, B1); PG8_BAR; PG8_SCHED;
            PG8_LDA(At, 1, 1); PG8_STAGE(PG8_SB(1, 0), b3, voffB); PG8_STAGE(PG8_SB(1, 1), b3 + hstep, voffB); PG8_STAGE(PG8_SA(1, 0), a3, voffA);
            PG8_WAIT_V(8); PG8_WAIT_L(0); PG8_BAR; PG8_MMA(1, 0, At, B0); PG8_MMA(1, 1, At, B1); PG8_BAR; PG8_SCHED;
            } else {
            PG8_LDB(B0, 0, 0); PG8_SCHED; PG8_LDA(At, 0, 0); PG8_STAGE(PG8_SA(1, 1), a1 + hstep, voffA);
            PG8_WAIT_L(8); PG8_BAR; PG8_WAIT_L(0); PG8_MMA(0, 0, At, B0); PG8_BAR; PG8_SCHED;
            PG8_LDB(B1, 0, 1); PG8_STAGE(PG8_SB(0, 0), b2, voffB);
            PG8_BAR; PG8_WAIT_L(0); PG8_MMA(0, 1, At, B1); PG8_BAR;
            PG8_LDA(At, 0, 1); PG8_STAGE(PG8_SA(0, 0), a2, voffA);
            PG8_BAR; PG8_WAIT_L(0); PG8_MMA(1, 0, At, B0); PG8_BAR; PG8_SCHED;
            PG8_STAGE(PG8_SB(0, 1), b2 + hstep, voffB);
            PG8_WAIT_V(6); PG8_BAR; PG8_MMA(1, 1, At, B1); PG8_BAR;
            PG8_LDB(B0, 1, 0); PG8_SCHED; PG8_LDA(At, 1, 0); PG8_STAGE(PG8_SA(0, 1), a2 + hstep, voffA);
            PG8_WAIT_L(8); PG8_BAR; PG8_WAIT_L(0); PG8_MMA(0, 0, At, B0); PG8_BAR; PG8_SCHED;
            PG8_LDB(B1, 1, 1); PG8_STAGE(PG8_SB(1, 0), b3, voffB);
            PG8_BAR; PG8_WAIT_L(0); PG8_MMA(0, 1, At, B1); PG8_BAR;
            PG8_LDA(At, 1, 1); PG8_STAGE(PG8_SA(1, 0), a3, voffA);
            PG8_BAR; PG8_WAIT_L(0); PG8_MMA(1, 0, At, B0); PG8_BAR; PG8_SCHED;
            PG8_STAGE(PG8_SB(1, 1), b3 + hstep, voffB);
            PG8_WAIT_V(6); PG8_BAR; PG8_MMA(1, 1, At, B1); PG8_BAR;
            }
        }
        if constexpr (ALIGN_EPI) { if (wr == 0) PG8_BAR; }
        if constexpr (!Epi::AFTER_DRAIN) { E(acc, cur, wr, wc, fr, fq); S.done(cur); }
        if (!has_next) break;
#pragma unroll
        for (int a = 0; a < 2; ++a)
#pragma unroll
            for (int b = 0; b < 2; ++b)
#pragma unroll
                for (int m = 0; m < 4; ++m)
#pragma unroll
                    for (int n = 0; n < 2; ++n) acc[a][b][m][n] = (f32x4){0.f, 0.f, 0.f, 0.f};
        cur = nxt; cA = nA; cB = nB; ++ui;
        if constexpr (ALIGN_EPI) { if (wr == 1) PG8_BAR; }
    }
    PG8_WAIT_V(0);
    if constexpr (!ALIGN_EPI) { if (wr == 0) PG8_BAR; }
    PG8_BAR;
    if constexpr (Epi::AFTER_DRAIN) { E.fused(acc, cur, wr, wc, fr, fq, lds, wid, lane); S.done(cur); }
#undef PG8_SA
#undef PG8_SB
#undef PG8_STAGE
#undef PG8_LDA
#undef PG8_LDB
#undef PG8_MMA
#undef PG8_WAIT_V
#undef PG8_WAIT_L
#undef PG8_BAR
#undef PG8_SCHED
}
}
#define LAS __attribute__((address_space(3)))
typedef unsigned short bf16;
typedef float f32x4 __attribute__((ext_vector_type(4)));
typedef float f32x2 __attribute__((ext_vector_type(2)));
typedef unsigned u32x4 __attribute__((ext_vector_type(4)));
typedef unsigned u32x2 __attribute__((ext_vector_type(2)));
typedef short bf16x8 __attribute__((ext_vector_type(8)));
typedef short s16x4 __attribute__((ext_vector_type(4)));

constexpr int D = 2048, SEQ = 8192, MP = 16384, MS = 512, M = MP + MS, NBI = 18;
constexpr int AW = 1024, DFF = 5632, NQKVG = 12288, VW = 4096, NMOD = 12288;
constexpr float EPS = 1e-6f;
constexpr int LDS_BYTES = 147456;

constexpr size_t OUT_Y = 0, OUT_POOLP = 34603008, OUT_POOLS = 34633728, OUT_VS = 34879488, OUT_RETP = 35403776, OUT_RETS = 37500928;
constexpr size_t WS_BAR = 0;
constexpr size_t WS_MODS = 65536;
constexpr size_t WS_COS = 3u << 20, WS_SIN = WS_COS + 4194304;
constexpr size_t WS_WSA = WS_SIN + 4194304;
constexpr size_t WS_WSB = WS_WSA + 262144;
constexpr size_t WS_WPT = WS_WSB + 262144;
constexpr size_t WS_PP = WS_WPT + 524288;
constexpr size_t WS_PS = WS_PP + 16777216;
constexpr size_t WS_W = 32u << 20;
constexpr size_t W0_IN = 0, W0_OUT = W0_IN + (size_t)3072 * 2048 * 2, W0_GU = W0_OUT + (size_t)2048 * 2048 * 2, W0_DN = W0_GU + (size_t)11264 * 2048 * 2;
constexpr size_t W1_IN = 0, W1_OUT = W1_IN + (size_t)12288 * 2048 * 2, W1_GU = W1_OUT + (size_t)2048 * 4096 * 2, W1_DN = W1_GU + (size_t)11264 * 2048 * 2;
constexpr size_t W_BYTES = W1_DN + (size_t)2048 * 5632 * 2;
constexpr size_t WS_H = WS_W + W_BYTES;
constexpr size_t WS_R = WS_H + (size_t)M * 2048 * 2;
constexpr size_t R_U = 0, R_V = R_U + (size_t)M * 1024 * 2, R_XB = R_V + (size_t)M * 1024 * 2;
constexpr size_t R_ACT = 0;
constexpr size_t R_Q = 0, R_K = R_Q + (size_t)M * 2048 * 2, R_VV = R_K + (size_t)M * 2048 * 2, R_G = R_VV + (size_t)M * 4096 * 2, R_O = R_G + (size_t)M * 4096 * 2;
constexpr size_t WS_END = WS_R + R_O + (size_t)M * 4096 * 2;
static_assert(WS_PS + 262144 <= WS_W, "ws map");
static_assert(WS_END <= 850000000ull, "ws too large");

__device__ __forceinline__ float bf2f(unsigned h) { return __uint_as_float(h << 16); }
typedef __bf16 bf16x2_t __attribute__((ext_vector_type(2)));
__device__ __forceinline__ unsigned pk2(float lo, float hi) { const f32x2 v = {lo, hi}; return __builtin_bit_cast(unsigned, __builtin_convertvector(v, bf16x2_t)); }
__device__ __forceinline__ float silu_f(float x) { return x * __builtin_amdgcn_rcpf(1.0f + __expf(-x)); }
__device__ __forceinline__ float gelu_tanh_f(float x) { const float z = 0.7978845608028654f * (x + 0.044715f * x * x * x); return x * __builtin_amdgcn_rcpf(1.0f + __expf(-2.0f * z)); }
__device__ __forceinline__ float wave_sum(float v) {
#pragma unroll
    for (int o = 1; o < 64; o <<= 1) v += __shfl_xor(v, o);
    return v;
}
__device__ __forceinline__ void unpack8(const u32x4 w, float (&f)[8]) {
    f[0] = __uint_as_float(w.x << 16); f[1] = __uint_as_float(w.x & 0xffff0000u); f[2] = __uint_as_float(w.y << 16); f[3] = __uint_as_float(w.y & 0xffff0000u);
    f[4] = __uint_as_float(w.z << 16); f[5] = __uint_as_float(w.z & 0xffff0000u); f[6] = __uint_as_float(w.w << 16); f[7] = __uint_as_float(w.w & 0xffff0000u);
}
__device__ __forceinline__ u32x4 pack8(const float (&f)[8]) { u32x4 w; w.x = pk2(f[0], f[1]); w.y = pk2(f[2], f[3]); w.z = pk2(f[4], f[5]); w.w = pk2(f[6], f[7]); return w; }
__device__ __forceinline__ int row_bi(int row) { return row < MP ? (row >> 13) : 2 + ((row - MP) >> 5); }
__device__ __forceinline__ float head_log_g(int h) { return log1pf(-exp2f(-5.0f - (float)h)); }
#define MFMA16(a, b, c) __builtin_amdgcn_mfma_f32_16x16x32_bf16((a), (b), (c), 0, 0, 0)
__device__ __forceinline__ int hm_row(int r, int h) { return r < MP ? (((r >> 13) * 8 + h) << 13) + (r & 8191) : MP * 8 + ((((r - MP) >> 5) * 8 + h) << 5) + ((r - MP) & 31); }
struct EpiInAB {
    static constexpr bool PERM = true, AFTER_DRAIN = false;
    bf16* U; bf16* V; bf16* XB; float* poolP; float* poolS;
    __device__ __forceinline__ void operator()(const f32x4 (&acc)[2][2][4][2], const pg8::Unit& u, int wr, int wc, int fr, int fq) const {
        const int t = u.pn >> 2, colt = (u.pn & 3) * 256 + wc * 32 + 8 * fq;
        bf16* base = U + (size_t)t * ((size_t)M * 1024);
#pragma unroll
        for (int ai = 0; ai < 2; ++ai)
#pragma unroll
            for (int m = 0; m < 4; ++m) {
                const int row = u.pm * 256 + ai * 128 + wr * 64 + m * 16 + fr;
                bf16* rowp = base + (size_t)row * 1024 + colt;
                float* sp = nullptr;
                if (t == 2) {
                    if (row < MP) { const int pos = row & 8191; if (pos >= 8177) sp = poolP + ((size_t)(row >> 13) * 15 + (pos - 8177)) * 1024 + colt; }
                    else { const int i = (row - MP) & 31; if (i >= 17) sp = poolS + ((size_t)((row - MP) >> 5) * 15 + (i - 17)) * 1024 + colt; }
                }
#pragma unroll
                for (int bj = 0; bj < 2; ++bj) {
                    f32x4 v0 = acc[ai][bj][m][0], v1 = acc[ai][bj][m][1];
                    if (t < 2) {
#pragma unroll
                        for (int j = 0; j < 4; ++j) { v0[j] = gelu_tanh_f(v0[j]); v1[j] = gelu_tanh_f(v1[j]); }
                    }
                    u32x4 w; w.x = pk2(v0[0], v0[1]); w.y = pk2(v0[2], v0[3]); w.z = pk2(v1[0], v1[1]); w.w = pk2(v1[2], v1[3]);
                    *(u32x4*)(rowp + bj * 128) = w;
                    if (sp) { *(f32x4*)(sp + bj * 128) = v0; *(f32x4*)(sp + bj * 128 + 4) = v1; }
                }
            }
    }
};
struct EpiRes {
    static constexpr bool PERM = false, AFTER_DRAIN = false;
    const float* baseP; const float* baseS; float* out; const float* gate;
    __device__ __forceinline__ void operator()(const f32x4 (&acc)[2][2][4][2], const pg8::Unit& u, int wr, int wc, int fr, int fq) const {
        const int col0 = u.pn * 256 + wc * 32 + 4 * fq;
#pragma unroll
        for (int ai = 0; ai < 2; ++ai)
#pragma unroll
            for (int m = 0; m < 4; ++m) {
                const int row = u.pm * 256 + ai * 128 + wr * 64 + m * 16 + fr;
                const float* bp = row < MP ? baseP + (size_t)row * D : baseS + (size_t)(row - MP) * D;
                const float* gp = gate + (size_t)row_bi(row) * NMOD;
                float* op = out + (size_t)row * D;
#pragma unroll
                for (int bj = 0; bj < 2; ++bj)
#pragma unroll
                    for (int n = 0; n < 2; ++n) { const int c = col0 + bj * 128 + n * 16;
                        const f32x4 b = *(const f32x4*)(bp + c), g = *(const f32x4*)(gp + c);
                        *(f32x4*)(op + c) = b + g * acc[ai][bj][m][n]; }
                if (m & 1) asm volatile("" ::: "memory");
            }
    }
};
struct EpiSwiGLU {
    static constexpr bool PERM = true, AFTER_DRAIN = false;
    bf16* ACT;
    __device__ __forceinline__ void operator()(const f32x4 (&acc)[2][2][4][2], const pg8::Unit& u, int wr, int wc, int fr, int fq) const {
        const int col0 = u.pn * 128 + wc * 32 + 8 * fq;
#pragma unroll
        for (int ai = 0; ai < 2; ++ai)
#pragma unroll
            for (int m = 0; m < 4; ++m) {
                const int row = u.pm * 256 + ai * 128 + wr * 64 + m * 16 + fr;
                float o[8];
#pragma unroll
                for (int n = 0; n < 2; ++n)
#pragma unroll
                    for (int j = 0; j < 4; ++j) o[n * 4 + j] = silu_f(acc[ai][0][m][n][j]) * acc[ai][1][m][n][j];
                *(u32x4*)(ACT + (size_t)row * DFF + col0) = pack8(o);
            }
    }
};
struct EpiQKVG {
    static constexpr bool PERM = true, AFTER_DRAIN = false;
    bf16* Q; bf16* K; bf16* V; bf16* G; const float* COS; const float* SIN;
    __device__ __forceinline__ void operator()(const f32x4 (&acc)[2][2][4][2], const pg8::Unit& u, int wr, int wc, int fr, int fq) const {
        const int pn = u.pn;
        if (pn < 16) {
            const int h = pn & 7; const bool isk = pn >= 8; const float lg = head_log_g(h) * 1.4426950408889634f;
            bf16* base = Q + (isk ? (size_t)M * 2048 : (size_t)0) + wc * 32 + 8 * fq;
            const int ch = wc * 32 + 8 * fq;
#pragma unroll
            for (int ai = 0; ai < 2; ++ai)
#pragma unroll
                for (int m = 0; m < 4; ++m) {
                    const int row = u.pm * 256 + ai * 128 + wr * 64 + m * 16 + fr;
                    int pos, n, L;
                    if (row < MP) { pos = row & 8191; n = pos & 63; L = 64; } else { n = (row - MP) & 31; pos = 2048 + n; L = 32; }
                    const float sc = isk ? 0.0625f * exp2f(lg * (float)(L - 1 - n)) : exp2f(lg * (float)(n + 1));
                    const f32x4 c0 = *(const f32x4*)(COS + (size_t)pos * 128 + ch), c1 = *(const f32x4*)(COS + (size_t)pos * 128 + ch + 4);
                    const f32x4 s0 = *(const f32x4*)(SIN + (size_t)pos * 128 + ch), s1 = *(const f32x4*)(SIN + (size_t)pos * 128 + ch + 4);
                    float o1[8], o2[8];
#pragma unroll
                    for (int j = 0; j < 4; ++j) {
                        const float a0 = acc[ai][0][m][0][j], b0 = acc[ai][1][m][0][j], a1 = acc[ai][0][m][1][j], b1 = acc[ai][1][m][1][j];
                        o1[j] = (a0 * c0[j] - b0 * s0[j]) * sc; o2[j] = (a0 * s0[j] + b0 * c0[j]) * sc;
                        o1[4 + j] = (a1 * c1[j] - b1 * s1[j]) * sc; o2[4 + j] = (a1 * s1[j] + b1 * c1[j]) * sc;
                    }
                    const int hrow = hm_row(row, h);
                    if (isk) { const size_t hr = (size_t)hrow * 256; *(u32x4*)(base + hr) = pack8(o1); *(u32x4*)(base + hr + 128) = pack8(o2); }
                    else {
                        bf16* qt = Q + ((size_t)(hrow >> 4) * 8 + wc) * 512 + (fq * 16 + (hrow & 15)) * 8;
                        *(u32x4*)qt = pack8(o1); *(u32x4*)(qt + 4 * 512) = pack8(o2); }
                }
        } else {
            const bool isg = pn >= 32; const int hv = (pn - 16) >> 1;
            bf16* base = V + (isg ? (size_t)M * 4096 + (size_t)(pn - 32) * 256 : (size_t)((pn - 16) & 1) * 256) + wc * 32 + 8 * fq;
#pragma unroll
            for (int ai = 0; ai < 2; ++ai)
#pragma unroll
                for (int m = 0; m < 4; ++m) {
                    const int row = u.pm * 256 + ai * 128 + wr * 64 + m * 16 + fr;
#pragma unroll
                    for (int bj = 0; bj < 2; ++bj) {
                        float o[8];
#pragma unroll
                        for (int n = 0; n < 2; ++n)
#pragma unroll
                            for (int j = 0; j < 4; ++j) { const float x = acc[ai][bj][m][n][j]; o[n * 4 + j] = isg ? silu_f(x) : x; }
                        *(u32x4*)(base + (isg ? (size_t)row * VW : (size_t)hm_row(row, hv) * 512) + bj * 128) = pack8(o);
                    }
                }
        }
    }
};
struct SplitOrder {
    int nN, KS, KL, G, c;
    __device__ __forceinline__ bool next(int i, pg8::Unit& u) const { const int L = i * G + c; if (L >= 2 * nN * KS) return false; u.pm = 64 + (L & 1); const int r = L >> 1; u.pn = r % nN; u.k0 = (r / nN) * KL; return true; }
    __device__ __forceinline__ void a_ready(const pg8::Unit&) const {}
    __device__ __forceinline__ void done(const pg8::Unit&) const {}
};
struct EpiPartial {
    static constexpr bool PERM = false, AFTER_DRAIN = false;
    float* PART; int KL;
    __device__ __forceinline__ void operator()(const f32x4 (&acc)[2][2][4][2], const pg8::Unit& u, int wr, int wc, int fr, int fq) const {
        const int col0 = u.pn * 256 + wc * 32 + 4 * fq, ks = u.k0 / KL;
#pragma unroll
        for (int ai = 0; ai < 2; ++ai)
#pragma unroll
            for (int m = 0; m < 4; ++m) {
                const int r = (u.pm - 64) * 256 + ai * 128 + wr * 64 + m * 16 + fr;
                float* op = PART + ((size_t)ks * MS + r) * D;
#pragma unroll
                for (int bj = 0; bj < 2; ++bj)
#pragma unroll
                    for (int n = 0; n < 2; ++n) *(f32x4*)(op + col0 + bj * 128 + n * 16) = acc[ai][bj][m][n];
            }
    }
};
__device__ __forceinline__ void transpose_item(const float* W, int K, int N, bf16* WT, int k0, int n0, int drow0, LAS float* scr, int lane) {
    float wv[32];
#pragma unroll
    for (int i = 0; i < 32; ++i) { const int kk = 2 * i + (lane >> 5); wv[i] = W[(size_t)(k0 + kk) * N + n0 + (lane & 31)]; }
#pragma unroll
    for (int i = 0; i < 32; ++i) { const int kk = 2 * i + (lane >> 5); scr[kk * 33 + (lane & 31)] = wv[i]; }
    asm volatile("s_waitcnt lgkmcnt(0)" ::: "memory");
    const int c = lane & 7;
#pragma unroll
    for (int j = 0; j < 4; ++j) { const int n = (lane >> 3) + 8 * j; const LAS float* s = scr + (8 * c) * 33 + n;
        u32x4 o; o.x = pk2(s[0 * 33], s[1 * 33]); o.y = pk2(s[2 * 33], s[3 * 33]); o.z = pk2(s[4 * 33], s[5 * 33]); o.w = pk2(s[6 * 33], s[7 * 33]);
        *(u32x4*)(WT + (size_t)(drow0 + n) * K + k0 + 8 * c) = o; }
    asm volatile("s_waitcnt lgkmcnt(0)" ::: "memory");
}
__device__ __forceinline__ void convert_weight(const float* W, int K, int N, bf16* WT, int mode, LAS float* scr, int lane, int gw, int ngw) {
    const int nblk = N / 32, nitems = (K / 64) * nblk;
    for (int it = gw; it < nitems; it += ngw) {
        const int kb = it / nblk, nb = it % nblk, n0 = nb * 32;
        int drow0 = n0;
        if (mode == 1) { if (n0 < DFF) drow0 = (n0 >> 7) * 256 + (n0 & 127); else { const int j0 = n0 - DFF; drow0 = (j0 >> 7) * 256 + 128 + (j0 & 127); } }
        transpose_item(W, K, N, WT, kb * 64, n0, drow0, scr, lane);
    }
}

__device__ __forceinline__ void ph_prologue(const float* const* in, unsigned char* ws, LAS unsigned char* lds) {
    const int tid = threadIdx.x, lane = tid & 63, wave = tid >> 6, G = gridDim.x;
    const float* c_p = in[2]; const float* c_s = in[3]; const float* w_ada = in[6]; const float* b_ada = in[7];
    float* mods = (float*)(ws + WS_MODS);
    LAS float* sc = (LAS float*)lds;
    LAS float* red = (LAS float*)(lds + 73728);
    for (int it = blockIdx.x; it < 192; it += G) {
        const int l = it / 96, nb = it % 96;
        const float* W = w_ada + (size_t)l * D * NMOD;
        f32x4 acc[NBI];
#pragma unroll
        for (int b = 0; b < NBI; ++b) acc[b] = (f32x4){0.f, 0.f, 0.f, 0.f};
        const int hh = lane >> 5, c4 = lane & 31;
        for (int kh = 0; kh < 2; ++kh) {
            __syncthreads();
            for (int e = tid; e < NBI * 1024; e += 512) { const int bi = e >> 10, kk = e & 1023;
                const float cv = bi < 2 ? c_p[bi * D + kh * 1024 + kk] : c_s[(bi - 2) * D + kh * 1024 + kk]; sc[e] = cv / (1.0f + __expf(-cv)); }
            __syncthreads();
            const float* wp = W + (size_t)(kh * 1024 + wave * 128 + hh) * NMOD + nb * 128 + c4 * 4;
            for (int j0 = 0; j0 < 64; j0 += 16) {
                f32x4 wv[16];
#pragma unroll
                for (int j = 0; j < 16; ++j) wv[j] = __builtin_nontemporal_load((const f32x4*)(wp + (size_t)(2 * (j0 + j)) * NMOD));
#pragma unroll
                for (int j = 0; j < 16; ++j) { const int kk = wave * 128 + 2 * (j0 + j) + hh;
#pragma unroll
                    for (int b = 0; b < NBI; ++b) { const float s = sc[b * 1024 + kk]; acc[b] += s * wv[j]; } }
            }
        }
#pragma unroll
        for (int b = 0; b < NBI; ++b)
#pragma unroll
            for (int q = 0; q < 4; ++q) acc[b][q] += __shfl_xor(acc[b][q], 32);
        if (lane < 32) {
#pragma unroll
            for (int b = 0; b < NBI; ++b) *(LAS f32x4*)(red + (wave * NBI + b) * 128 + c4 * 4) = acc[b];
        }
        __syncthreads();
        for (int e = tid; e < NBI * 128; e += 512) { const int bi = e >> 7, cc = e & 127;
            float s = b_ada[l * NMOD + nb * 128 + cc];
#pragma unroll
            for (int w = 0; w < 8; ++w) s += red[(w * NBI + bi) * 128 + cc];
            mods[(size_t)(l * NBI + bi) * NMOD + nb * 128 + cc] = s; }
    }
    __syncthreads();
    {
        LAS float* scr = (LAS float*)(lds + wave * 16384);
        const int gw = blockIdx.x * 8 + wave, ngw = G * 8;
        unsigned char* wb = ws + WS_W;
        convert_weight(in[11], D, 3072, (bf16*)(wb + W0_IN), 0, scr, lane, gw, ngw);
        convert_weight(in[18], D, D, (bf16*)(wb + W0_OUT), 0, scr, lane, gw, ngw);
        convert_weight(in[21], D, 2 * DFF, (bf16*)(wb + W0_GU), 1, scr, lane, gw, ngw);
        convert_weight(in[22], DFF, D, (bf16*)(wb + W0_DN), 0, scr, lane, gw, ngw);
    }
    const int gt = blockIdx.x * 512 + tid, ngt = G * 512;
    { const float* w_s = in[14]; bf16* wsa = (bf16*)(ws + WS_WSA); bf16* wsb = (bf16*)(ws + WS_WSB);
      for (int e = gt; e < 8 * 128 * 128; e += ngt) { const int g = e >> 14, t = (e >> 7) & 127, s = e & 127;
          const float a = ((s >> 6) <= (t >> 6)) ? w_s[e] : 0.f;
          const float b = ((s >> 5) == (t >> 5)) ? w_s[(g * 128 + (t & 31)) * 128 + (s & 31)] : 0.f;
          wsa[e] = (bf16)(pk2(a, 0.f) & 0xffffu); wsb[e] = (bf16)(pk2(b, 0.f) & 0xffffu); } }
    { const float* w_pool = in[16]; bf16* wpt = (bf16*)(ws + WS_WPT);
      for (int e = gt; e < 4 * 256 * 256; e += ngt) { const int g = e >> 16, d = (e >> 8) & 255, c = e & 255;
          wpt[e] = (bf16)(pk2(w_pool[(g * 256 + c) * 256 + d], 0.f) & 0xffffu); } }
    { float* COS = (float*)(ws + WS_COS); float* SIN = (float*)(ws + WS_SIN);
      for (int e = gt; e < 8192 * 128; e += ngt) { const int pos = e >> 7, ch = e & 127;
          const float freq = powf(10000.0f, -(float)ch / 128.0f); const float ang = (float)pos * freq;
          COS[e] = cosf(ang); SIN[e] = sinf(ang); } }
}

__device__ __forceinline__ void ph_norm(const float* xP, const float* xS, const float* g, const float* shiftb, const float* scaleb, bf16* H,
                                        const float* part, int KS, const float* gate, float* Xout) {
    const int lane = threadIdx.x & 63, gw = blockIdx.x * 8 + (threadIdx.x >> 6), ngw = gridDim.x * 8;
    for (int row = gw; row < M; row += ngw) {
        const f32x4* xr = (const f32x4*)(row < MP ? xP + (size_t)row * D : xS + (size_t)(row - MP) * D) + lane;
        const int bi = row_bi(row);
        f32x4 v[8];
#pragma unroll
        for (int j = 0; j < 8; ++j) v[j] = xr[64 * j];
        if (part && row >= MP) {
            f32x4 sacc[8];
#pragma unroll
            for (int j = 0; j < 8; ++j) sacc[j] = (f32x4){0.f, 0.f, 0.f, 0.f};
            for (int ks = 0; ks < KS; ++ks) { const f32x4* pp = (const f32x4*)(part + ((size_t)ks * MS + (row - MP)) * D) + lane;
#pragma unroll
                for (int j = 0; j < 8; ++j) sacc[j] += pp[64 * j]; }
            const f32x4* gt = (const f32x4*)(gate + (size_t)bi * NMOD) + lane; f32x4* xo = (f32x4*)(Xout + (size_t)row * D) + lane;
#pragma unroll
            for (int j = 0; j < 8; ++j) { v[j] += gt[64 * j] * sacc[j]; xo[64 * j] = v[j]; }
        }
        float s = 0.f;
#pragma unroll
        for (int j = 0; j < 8; ++j) s += (v[j].x * v[j].x + v[j].y * v[j].y) + (v[j].z * v[j].z + v[j].w * v[j].w);
        const float r = 1.0f / sqrtf(wave_sum(s) * (1.0f / D) + EPS);
        const f32x4* gp = (const f32x4*)g + lane; const f32x4* sh = (const f32x4*)(shiftb + (size_t)bi * NMOD) + lane; const f32x4* sc = (const f32x4*)(scaleb + (size_t)bi * NMOD) + lane;
        u32x2* o = (u32x2*)(H + (size_t)row * D) + lane;
#pragma unroll
        for (int j = 0; j < 8; ++j) { const f32x4 y = v[j] * r * gp[64 * j] * (1.0f + sc[64 * j]) + sh[64 * j]; u32x2 w; w.x = pk2(y.x, y.y); w.y = pk2(y.z, y.w); o[64 * j] = w; }
    }
}
__device__ __forceinline__ void ph_final_norm(float* X, const float* g, const float* part, int KS, const float* gate) {
    const int lane = threadIdx.x & 63, gw = blockIdx.x * 8 + (threadIdx.x >> 6), ngw = gridDim.x * 8;
    for (int row = gw; row < M; row += ngw) {
        f32x4* xr = (f32x4*)(X + (size_t)row * D) + lane;
        f32x4 v[8];
#pragma unroll
        for (int j = 0; j < 8; ++j) v[j] = xr[64 * j];
        if (row >= MP) {
            f32x4 sacc[8];
#pragma unroll
            for (int j = 0; j < 8; ++j) sacc[j] = (f32x4){0.f, 0.f, 0.f, 0.f};
            for (int ks = 0; ks < KS; ++ks) { const f32x4* pp = (const f32x4*)(part + ((size_t)ks * MS + (row - MP)) * D) + lane;
#pragma unroll
                for (int j = 0; j < 8; ++j) sacc[j] += pp[64 * j]; }
            const f32x4* gt = (const f32x4*)(gate + (size_t)row_bi(row) * NMOD) + lane;
#pragma unroll
            for (int j = 0; j < 8; ++j) v[j] += gt[64 * j] * sacc[j];
        }
        float s = 0.f;
#pragma unroll
        for (int j = 0; j < 8; ++j) s += (v[j].x * v[j].x + v[j].y * v[j].y) + (v[j].z * v[j].z + v[j].w * v[j].w);
        const float r = 1.0f / sqrtf(wave_sum(s) * (1.0f / D) + EPS);
        const f32x4* gp = (const f32x4*)g + lane;
#pragma unroll
        for (int j = 0; j < 8; ++j) xr[64 * j] = v[j] * r * gp[64 * j];
    }
}

__device__ __forceinline__ void ph_mixer(const float* const* in, unsigned char* ws, float* out, LAS unsigned char* lds) {
    const int tid = threadIdx.x, lane = tid & 63, wave = tid >> 6, fr = lane & 15, fq = lane >> 4;
    const bf16* U = (const bf16*)(ws + WS_R + R_U); const bf16* V = (const bf16*)(ws + WS_R + R_V); const bf16* XB = (const bf16*)(ws + WS_R + R_XB);
    bf16* CAT = (bf16*)(ws + WS_H);
    const float* ln_g = in[12]; const float* ln_b = in[13]; const float* b_s = in[15]; const float* pool_scale = in[17]; const float* hist = in[4];
    float* vs_out = out + OUT_VS;
    for (int unit = blockIdx.x; unit < 512 + 64; unit += gridDim.x) {
        const bool subu = unit >= 512; const int su = unit - 512;
        const int blk = subu ? 128 + (su >> 4) : unit >> 2, part = subu ? (su >> 2) & 3 : unit & 3, sub = su & 3;
        const int gi_lo = subu ? (part < 2 ? sub : sub >> 1) : 0, gi_hi = subu ? gi_lo + 1 : (part < 2 ? 4 : 2), dh_lo = subu ? (sub & 1) : 0, dh_hi = subu ? dh_lo + 1 : 2;
        const bool samp = blk >= 128;
        const int R0 = samp ? MP + (blk - 128) * 128 : blk * 128;
        if (part < 2) {
            LAS float* stat = (LAS float*)lds;
            LAS bf16* As = (LAS bf16*)(lds + 1024);
            LAS bf16* Bs = (LAS bf16*)(lds + 1024 + 34816);
            __syncthreads();
            for (int r = 0; r < 16; ++r) {
                const int t = wave * 16 + r;
                const u32x4* vp = (const u32x4*)(V + (size_t)(R0 + t) * 1024) + lane * 2;
                float f[16]; { float a[8], b[8]; unpack8(vp[0], a); unpack8(vp[1], b);
#pragma unroll
                    for (int j = 0; j < 8; ++j) { f[j] = a[j]; f[8 + j] = b[j]; } }
                float s = 0.f;
#pragma unroll
                for (int j = 0; j < 16; ++j) s += f[j];
                const float mean = wave_sum(s) * (1.0f / 1024.0f); float q = 0.f;
#pragma unroll
                for (int j = 0; j < 16; ++j) { const float d = f[j] - mean; q += d * d; }
                const float rstd = 1.0f / sqrtf(wave_sum(q) * (1.0f / 1024.0f) + EPS);
                if (lane == 0) { stat[2 * t] = mean; stat[2 * t + 1] = rstd; }
            }
            const bf16* wsrc = (const bf16*)(ws + (samp ? WS_WSB : WS_WSA));
            for (int gi = gi_lo; gi < gi_hi; ++gi) {
                const int g = part * 4 + gi;
                __syncthreads();
#pragma unroll
                for (int i = 0; i < 4; ++i) { const int e = tid + 512 * i, row = e >> 4, cc = e & 15;
                    *(LAS u32x4*)(As + row * 136 + cc * 8) = *(const u32x4*)(wsrc + (size_t)(g * 128 + row) * 128 + cc * 8); }
#pragma unroll
                for (int i = 0; i < 4; ++i) { const int e = tid + 512 * i, s = e >> 4, c8 = e & 15;
                    float f[8]; unpack8(*(const u32x4*)(V + (size_t)(R0 + s) * 1024 + g * 128 + c8 * 8), f);
                    const float mean = stat[2 * s], rstd = stat[2 * s + 1];
                    const f32x4 g0 = *(const f32x4*)(ln_g + g * 128 + c8 * 8), g1 = *(const f32x4*)(ln_g + g * 128 + c8 * 8 + 4);
                    const f32x4 b0 = *(const f32x4*)(ln_b + g * 128 + c8 * 8), b1 = *(const f32x4*)(ln_b + g * 128 + c8 * 8 + 4);
#pragma unroll
                    for (int j = 0; j < 4; ++j) { f[j] = (f[j] - mean) * rstd * g0[j] + b0[j]; f[4 + j] = (f[4 + j] - mean) * rstd * g1[j] + b1[j]; }
                    if (samp) { float* vo = vs_out + (size_t)(R0 - MP + s) * 1024 + g * 128 + c8 * 8;
                        *(f32x4*)vo = (f32x4){f[0], f[1], f[2], f[3]}; *(f32x4*)(vo + 4) = (f32x4){f[4], f[5], f[6], f[7]}; }
#pragma unroll
                    for (int j = 0; j < 8; j += 2) { const unsigned w = pk2(f[j], f[j + 1]); Bs[(c8 * 8 + j) * 136 + s] = (bf16)(w & 0xffffu); Bs[(c8 * 8 + j + 1) * 136 + s] = (bf16)(w >> 16); }
                }
                __syncthreads();
                f32x4 acc[8];
#pragma unroll
                for (int ct = 0; ct < 8; ++ct) acc[ct] = (f32x4){0.f, 0.f, 0.f, 0.f};
#pragma unroll
                for (int ks = 0; ks < 4; ++ks) {
                    const bf16x8 a = *(const LAS bf16x8*)(As + (wave * 16 + fr) * 136 + ks * 32 + fq * 8);
#pragma unroll
                    for (int ct = 0; ct < 8; ++ct) { const bf16x8 b = *(const LAS bf16x8*)(Bs + (ct * 16 + fr) * 136 + ks * 32 + fq * 8); acc[ct] = MFMA16(b, a, acc[ct]); }
                }
                {
                    LAS float* Ew = (LAS float*)(lds + 1024 + 2 * 34816) + wave * (16 * 132);
                    const int t = wave * 16 + fr; const float bsv = b_s[g * 128 + (samp ? (t & 31) : t)];
#pragma unroll
                    for (int ct = 0; ct < 8; ++ct) *(LAS f32x4*)(Ew + fr * 132 + ct * 16 + 4 * fq) = acc[ct] + bsv;
#pragma unroll
                    for (int it = 0; it < 4; ++it) { const int rr = it * 4 + (lane >> 4), c0 = (lane & 15) * 8, tt = wave * 16 + rr;
                        const f32x4 m0 = *(const LAS f32x4*)(Ew + rr * 132 + c0), m1 = *(const LAS f32x4*)(Ew + rr * 132 + c0 + 4);
                        float uf[8]; unpack8(*(const u32x4*)(U + (size_t)(R0 + tt) * 1024 + g * 128 + c0), uf);
                        float o[8] = {uf[0] * m0[0], uf[1] * m0[1], uf[2] * m0[2], uf[3] * m0[3], uf[4] * m1[0], uf[5] * m1[1], uf[6] * m1[2], uf[7] * m1[3]};
                        *(u32x4*)(CAT + (size_t)(R0 + tt) * D + g * 128 + c0) = pack8(o); }
                }
            }
        } else {
            LAS bf16* As = (LAS bf16*)lds;
            LAS bf16* Bs = (LAS bf16*)(lds + 67584);
            const bf16* WPT = (const bf16*)(ws + WS_WPT);
            for (int gi = gi_lo; gi < gi_hi; ++gi) {
                const int g = (part - 2) * 2 + gi, w = 2 << g;
                __syncthreads();
                {
                    const int tl = tid >> 5, co = tid & 31, t0 = tl * 8, cb = g * 256 + co * 8;
                    int sb = 0, i0 = 0, p0 = 0;
                    if (samp) { sb = (blk - 128) * 4 + (t0 >> 5); i0 = t0 & 31; } else { p0 = (R0 & 8191) + t0; }
                    auto ldrow = [&](int dt, float (&f)[8]) {
                        if (samp) { const int i = i0 + dt;
                            if (i >= 0) unpack8(*(const u32x4*)(XB + (size_t)(R0 + t0 + dt) * 1024 + cb), f);
                            else { const float* hp = hist + ((size_t)sb * 15 + (15 + i)) * 1024 + cb; const f32x4 a = *(const f32x4*)hp, b = *(const f32x4*)(hp + 4);
                                f[0] = a.x; f[1] = a.y; f[2] = a.z; f[3] = a.w; f[4] = b.x; f[5] = b.y; f[6] = b.z; f[7] = b.w; } }
                        else { if (p0 + dt >= 0) unpack8(*(const u32x4*)(XB + (size_t)(R0 + t0 + dt) * 1024 + cb), f);
                            else {
#pragma unroll
                                for (int j = 0; j < 8; ++j) f[j] = 0.f; } }
                    };
                    float S[8], x[8], y[8];
#pragma unroll
                    for (int j = 0; j < 8; ++j) S[j] = 0.f;
                    for (int j = 1; j < w; ++j) { ldrow(-j, x);
#pragma unroll
                        for (int q = 0; q < 8; ++q) S[q] += x[q]; }
                    for (int tt = 0; tt < 8; ++tt) {
                        ldrow(tt, x);
#pragma unroll
                        for (int q = 0; q < 8; ++q) S[q] += x[q];
                        const int pos = samp ? 2048 + i0 + tt : p0 + tt; const float inv = 1.0f / (float)(w < pos + 1 ? w : pos + 1);
                        float pv[8];
#pragma unroll
                        for (int q = 0; q < 8; ++q) pv[q] = S[q] * inv - x[q];
                        *(LAS u32x4*)(As + (t0 + tt) * 264 + co * 8) = pack8(pv);
                        ldrow(tt - w + 1, y);
#pragma unroll
                        for (int q = 0; q < 8; ++q) S[q] -= y[q];
                    }
                }
                for (int dh = dh_lo; dh < dh_hi; ++dh) {
                    __syncthreads();
#pragma unroll
                    for (int i = 0; i < 8; ++i) { const int e = tid + 512 * i, d = e >> 5, c8 = e & 31;
                        *(LAS u32x4*)(Bs + d * 264 + c8 * 8) = *(const u32x4*)(WPT + (size_t)(g * 256 + dh * 128 + d) * 256 + c8 * 8); }
                    __syncthreads();
                    f32x4 acc[8];
#pragma unroll
                    for (int ct = 0; ct < 8; ++ct) acc[ct] = (f32x4){0.f, 0.f, 0.f, 0.f};
#pragma unroll
                    for (int ks = 0; ks < 8; ++ks) {
                        const bf16x8 a = *(const LAS bf16x8*)(As + (wave * 16 + fr) * 264 + ks * 32 + fq * 8);
#pragma unroll
                        for (int ct = 0; ct < 8; ++ct) { const bf16x8 b = *(const LAS bf16x8*)(Bs + (ct * 16 + fr) * 264 + ks * 32 + fq * 8); acc[ct] = MFMA16(b, a, acc[ct]); }
                    }
                    __syncthreads();
                    {
                        LAS float* Ew = (LAS float*)(lds + 67584) + wave * (16 * 132);
#pragma unroll
                        for (int ct = 0; ct < 8; ++ct) *(LAS f32x4*)(Ew + fr * 132 + ct * 16 + 4 * fq) = acc[ct];
#pragma unroll
                        for (int it = 0; it < 4; ++it) { const int rr = it * 4 + (lane >> 4), c0 = (lane & 15) * 8, tt = wave * 16 + rr, dcol = g * 256 + dh * 128 + c0;
                            const f32x4 m0 = *(const LAS f32x4*)(Ew + rr * 132 + c0), m1 = *(const LAS f32x4*)(Ew + rr * 132 + c0 + 4);
                            const f32x4 p0 = *(const f32x4*)(pool_scale + dcol), p1 = *(const f32x4*)(pool_scale + dcol + 4);
                            float o[8] = {m0[0] * p0[0], m0[1] * p0[1], m0[2] * p0[2], m0[3] * p0[3], m1[0] * p1[0], m1[1] * p1[1], m1[2] * p1[2], m1[3] * p1[3]};
                            *(u32x4*)(CAT + (size_t)(R0 + tt) * D + 1024 + dcol) = pack8(o); }
                    }
                }
            }
        }
    }
}
template <int L> __device__ __forceinline__ void scores_unit(const bf16* Q, const bf16* K, bf16* P, int row0, int h, int lane) {
    constexpr int NT = L / 16; const int fr = lane & 15, fq = lane >> 4;
    const float sc = exp2f(-(float)L * head_log_g(h) * 1.4426950408889634f);
    for (int lt = 0; lt < NT; ++lt) {
        f32x4 acc[NT];
#pragma unroll
        for (int mt = 0; mt < NT; ++mt) acc[mt] = (f32x4){0.f, 0.f, 0.f, 0.f};
#pragma unroll
        for (int ks = 0; ks < 8; ++ks) {
            const bf16x8 a = *(const bf16x8*)(Q + (((size_t)(row0 >> 4) + lt) * 8 + ks) * 512 + lane * 8);
#pragma unroll
            for (int mt = 0; mt < NT; ++mt) { const bf16x8 b = *(const bf16x8*)(K + (size_t)(row0 + mt * 16 + fr) * 256 + ks * 32 + fq * 8); acc[mt] = MFMA16(b, a, acc[mt]); }
        }
        const int l = lt * 16 + fr;
#pragma unroll
        for (int mt = 0; mt < NT; ++mt) { const int m0 = mt * 16 + 4 * fq; float v[4];
#pragma unroll
            for (int r = 0; r < 4; ++r) v[r] = (l >= m0 + r) ? acc[mt][r] * sc : 0.f;
            u32x2 o; o.x = pk2(v[0], v[1]); o.y = pk2(v[2], v[3]);
            if (L == 64) *(u32x2*)(P + ((lt * 2 + (mt >> 1)) * 64 + ((mt & 1) * 2 + (fq >> 1)) * 16 + fr) * 8 + (fq & 1) * 4) = o;
            else *(u32x2*)(P + l * L + m0) = o; }
    }
}
__device__ __forceinline__ void ph_scores(unsigned char* ws) {
    const int lane = threadIdx.x & 63, gw = blockIdx.x * 8 + (threadIdx.x >> 6), ngw = gridDim.x * 8;
    const bf16* Q = (const bf16*)(ws + WS_R + R_Q); const bf16* K = (const bf16*)(ws + WS_R + R_K);
    for (int unit = gw; unit < 2048 + 128; unit += ngw) {
        if (unit < 2048) scores_unit<64>(Q, K, (bf16*)(ws + WS_PP) + (size_t)unit * 4096, hm_row((unit >> 3) * 64, unit & 7), unit & 7, lane);
        else { const int su = unit - 2048; scores_unit<32>(Q, K, (bf16*)(ws + WS_PS) + (size_t)su * 1024, hm_row(MP + (su >> 3) * 32, su & 7), su & 7, lane); }
    }
}

constexpr int RQP = 272, RVP = 80, RPP = 72;
constexpr int R_QS = 0, R_KS = R_QS + 64 * RQP * 2, R_VS = R_KS + 64 * RQP * 2, R_PS = R_VS + 64 * RVP * 2, R_ST = R_PS + 64 * RPP * 2, R_LDS_END = R_ST + 64 * RQP * 2;
static_assert(R_LDS_END <= 131072, "retention LDS");
__device__ __forceinline__ bf16x8 tr_frag(const LAS bf16* base, int pitch) {
    const s16x4 lo = __builtin_amdgcn_ds_read_tr16_b64_v4i16((LAS s16x4*)(base)), hi = __builtin_amdgcn_ds_read_tr16_b64_v4i16((LAS s16x4*)(base + 4 * pitch));
    return (bf16x8){lo[0], lo[1], lo[2], lo[3], hi[0], hi[1], hi[2], hi[3]};
}
template <int L> __device__ __forceinline__ void ret_unit(const bf16* Qd, const bf16* Kd, const bf16* Vv, const bf16* P, size_t pstride, bf16* O, int row0, int nchunks, int h, int e0,
                                                         const float* S0, float* Sout, LAS unsigned char* lds) {
    const int tid = threadIdx.x, lane = tid & 63, wave = tid >> 6, fr = lane & 15, fq = lane >> 4, tq = (lane & 15) >> 2, tp = lane & 3;
    LAS bf16* Qs = (LAS bf16*)(lds + R_QS); LAS bf16* Ks = (LAS bf16*)(lds + R_KS); LAS bf16* Vs = (LAS bf16*)(lds + R_VS); LAS bf16* Ps = (LAS bf16*)(lds + R_PS); LAS bf16* ST = (LAS bf16*)(lds + R_ST);
    constexpr int NQ = L / 16, TPW = L / 32, NKS = L / 32;
    constexpr bool VALL = (L == 64);
    const float gL = exp2f((float)L * head_log_g(h) * 1.4426950408889634f);
    f32x4 S[2][4];
#pragma unroll
    for (int dti = 0; dti < 2; ++dti)
#pragma unroll
        for (int et = 0; et < 4; ++et)
#pragma unroll
            for (int r = 0; r < 4; ++r) S[dti][et][r] = S0 ? S0[(size_t)((2 * wave + dti) * 16 + 4 * fq + r) * 512 + e0 + et * 16 + fr] : 0.f;
    u32x4 rq[NQ], rk[NQ], rv, rp;
    rv = (u32x4){0u, 0u, 0u, 0u}; rp = rv;
    const bool vact = VALL || tid < 8 * L, pact = tid < L * (L / 8);
#define RET_LOAD(c) do { const size_t rb = (size_t)row0 + (size_t)(c) * L; \
        _Pragma("unroll") for (int i = 0; i < NQ; ++i) { const int e = tid + 512 * i, r = e >> 5, pc = e & 31; \
            rq[i] = *(const u32x4*)(Qd + rb * 256 + (size_t)e * 8); rk[i] = *(const u32x4*)(Kd + (rb + r) * 256 + pc * 8); } \
        if (vact) rv = *(const u32x4*)(Vv + (rb + (tid >> 3)) * 512 + e0 + (tid & 7) * 8); \
        if (pact) rp = *(const u32x4*)(P + (size_t)(c) * pstride + (size_t)(tid / (L / 8)) * L + (tid % (L / 8)) * 8); } while (0)
    RET_LOAD(0);
    for (int c = 0; c < nchunks; ++c) {
        __syncthreads();
#pragma unroll
        for (int i = 0; i < NQ; ++i) { const int e = tid + 512 * i, r = e >> 5, pc = e & 31; *(LAS u32x4*)(Qs + ((e >> 9) * 16 + (e & 15)) * RQP + ((e >> 6) & 7) * 32 + ((e >> 4) & 3) * 8) = rq[i]; *(LAS u32x4*)(Ks + r * RQP + pc * 8) = rk[i]; }
        if (vact) *(LAS u32x4*)(Vs + (tid >> 3) * RVP + (tid & 7) * 8) = rv;
        if (pact) *(LAS u32x4*)(Ps + (tid / (L / 8)) * RPP + (tid % (L / 8)) * 8) = rp;
#pragma unroll
        for (int dti = 0; dti < 2; ++dti)
#pragma unroll
            for (int et = 0; et < 4; ++et) { u32x2 w; w.x = pk2(S[dti][et][0], S[dti][et][1]); w.y = pk2(S[dti][et][2], S[dti][et][3]);
                *(LAS u32x2*)(ST + (et * 16 + fr) * RQP + (2 * wave + dti) * 16 + 4 * fq) = w; }
        __syncthreads();
        if (c + 1 < nchunks) RET_LOAD(c + 1);
#pragma unroll
        for (int i = 0; i < TPW; ++i) {
            const int t = wave * TPW + i, lt = t >> 2, et = t & 3;
            f32x4 o = (f32x4){0.f, 0.f, 0.f, 0.f};
#pragma unroll
            for (int ks = 0; ks < 8; ++ks) { const bf16x8 a = *(const LAS bf16x8*)(Qs + (lt * 16 + fr) * RQP + ks * 32 + fq * 8), b = *(const LAS bf16x8*)(ST + (et * 16 + fr) * RQP + ks * 32 + fq * 8); o = MFMA16(b, a, o); }
#pragma unroll
            for (int ks = 0; ks < NKS; ++ks) { const bf16x8 a = *(const LAS bf16x8*)(Ps + (lt * 16 + fr) * RPP + ks * 32 + fq * 8), b = tr_frag(Vs + (ks * 32 + 8 * fq + tq) * RVP + et * 16 + 4 * tp, RVP); o = MFMA16(b, a, o); }
            u32x2 w; w.x = pk2(o[0], o[1]); w.y = pk2(o[2], o[3]);
            *(u32x2*)(O + ((size_t)row0 + (size_t)c * L + lt * 16 + fr) * 512 + e0 + et * 16 + 4 * fq) = w;
        }
#pragma unroll
        for (int dti = 0; dti < 2; ++dti)
#pragma unroll
            for (int et = 0; et < 4; ++et) S[dti][et] = S[dti][et] * gL;
#pragma unroll
        for (int ks = 0; ks < NKS; ++ks) {
            bf16x8 bv[4];
#pragma unroll
            for (int et = 0; et < 4; ++et) bv[et] = tr_frag(Vs + (ks * 32 + 8 * fq + tq) * RVP + et * 16 + 4 * tp, RVP);
#pragma unroll
            for (int dti = 0; dti < 2; ++dti) { const bf16x8 ak = tr_frag(Ks + (ks * 32 + 8 * fq + tq) * RQP + (2 * wave + dti) * 16 + 4 * tp, RQP);
#pragma unroll
                for (int et = 0; et < 4; ++et) S[dti][et] = MFMA16(ak, bv[et], S[dti][et]); }
        }
    }
#undef RET_LOAD
#pragma unroll
    for (int dti = 0; dti < 2; ++dti)
#pragma unroll
        for (int et = 0; et < 4; ++et)
#pragma unroll
            for (int r = 0; r < 4; ++r) Sout[(size_t)((2 * wave + dti) * 16 + 4 * fq + r) * 512 + e0 + et * 16 + fr] = S[dti][et][r];
}

constexpr int P_KB = 0, P_VB = 2 * 64 * RQP * 2, P_VP = 48, P_ST = P_VB + 2 * 64 * P_VP * 2, P_END = P_ST + 2 * 32 * RQP * 2;
static_assert(P_END <= 131072, "prompt retention LDS");
template <int VAR> __device__ __forceinline__ void ret_prompt(const bf16* Qd, const bf16* Kd, const bf16* Vv, const bf16* P, bf16* O, int row0, int h, int e0, float* Sout, LAS unsigned char* lds) {
    const int tid = threadIdx.x, lane = tid & 63, wave = tid >> 6, fr = lane & 15, fq = lane >> 4, tq = (lane & 15) >> 2, tp = lane & 3;
    constexpr int NCH = 128;
    const float gL = exp2f(64.0f * head_log_g(h) * 1.4426950408889634f);
    const int lt = wave >> 1, et_o = wave & 1;
    f32x4 S[2][2], ocar = (f32x4){0.f, 0.f, 0.f, 0.f};
#pragma unroll
    for (int a = 0; a < 2; ++a)
#pragma unroll
        for (int b = 0; b < 2; ++b) S[a][b] = (f32x4){0.f, 0.f, 0.f, 0.f};
    u32x4 rkA[4], rkB[4], rvA, rvB; rvA = (u32x4){0u, 0u, 0u, 0u}; rvB = rvA;
    bf16x8 qA[4], qB[4], pA[1], pB[1];
    const char* kbase = (const char*)(Kd + (size_t)row0 * 256); const char* vbase = (const char*)(Vv + (size_t)row0 * 512 + e0);
    const char* qbase = (const char*)(Qd + (size_t)row0 * 256); const char* pbase = (const char*)P; char* obase = (char*)(O + (size_t)row0 * 512 + e0);
    unsigned koff[4];
#pragma unroll
    for (int i = 0; i < 4; ++i) { const int e = tid + 512 * i; koff[i] = (unsigned)(e * 16); }
    const unsigned voff = (unsigned)((((tid & 255) >> 2) * 512 + (tid & 3) * 8) * 2), qoff = (unsigned)(((lt * 8 + et_o * 4) * 512 + lane * 8) * 2), poff = (unsigned)(((lt * 2 + et_o) * 512 + lane * 8) * 2);
    const unsigned ooff = (unsigned)(((lt * 16 + fr) * 512 + et_o * 16 + 4 * fq) * 2);
    unsigned klds[4];
#pragma unroll
    for (int i = 0; i < 4; ++i) { const int e = tid + 512 * i; klds[i] = (unsigned)(P_KB + ((e >> 5) * RQP + (e & 31) * 8) * 2); }
    const unsigned vlds = (unsigned)(P_VB + (((tid & 255) >> 2) * P_VP + (tid & 3) * 8) * 2);
    LAS unsigned char* xo = lds + P_END;
    const unsigned xwr = (unsigned)(((lt * 2 + et_o) * 64 + lane) * 16), xrd = (unsigned)(((lt * 2 + (et_o ^ 1)) * 64 + lane) * 16);
#define RP_LOADKV(rk, rv, c) do { const char* kc_ = kbase + (size_t)(c) * (64 * 256 * 2); const char* vc_ = vbase + (size_t)(c) * (64 * 512 * 2); \
        _Pragma("unroll") for (int i = 0; i < 4; ++i) rk[i] = *(const u32x4*)(kc_ + koff[i]); rv = *(const u32x4*)(vc_ + voff); } while (0)
#define RP_STOREKV(rk, rv, b) do { _Pragma("unroll") for (int i = 0; i < 4; ++i) *(LAS u32x4*)(lds + (b) * (64 * RQP * 2) + klds[i]) = rk[i]; \
        *(LAS u32x4*)(lds + (b) * (64 * P_VP * 2) + vlds) = rv; } while (0)
#define RP_LOADQP(dq, dp, c) do { const char* qc_ = qbase + (size_t)(c) * (64 * 256 * 2) + qoff; const char* pc_ = pbase + (size_t)(c) * (8 * 4096 * 2) + poff; \
        _Pragma("unroll") for (int ks = 0; ks < 4; ++ks) dq[ks] = *(const bf16x8*)(qc_ + ks * 1024); \
        dp[0] = *(const bf16x8*)(pc_); } while (0)
#define RP_STOREST(b) do { _Pragma("unroll") for (int dti = 0; dti < 2; ++dti) _Pragma("unroll") for (int et = 0; et < 2; ++et) { u32x2 w; w.x = pk2(S[dti][et][0], S[dti][et][1]); w.y = pk2(S[dti][et][2], S[dti][et][3]); \
        *(LAS u32x2*)(lds + P_ST + (b) * (32 * RQP * 2) + ((et * 16 + fr) * RQP + (2 * wave + dti) * 16 + 4 * fq) * 2) = w; } } while (0)
#define RP_BODY(c, cur, rkX, rvX, qX, pX) do { \
        asm volatile("s_waitcnt lgkmcnt(0)" ::: "memory"); __builtin_amdgcn_s_barrier(); asm volatile("" ::: "memory"); \
        RP_STOREKV(rkX, rvX, (cur) ^ 1); \
        if (VAR != 2) { const int ck = (c) + 3 < NCH ? (c) + 3 : NCH - 1; RP_LOADKV(rkX, rvX, ck); } \
        const LAS bf16* Kc = (const LAS bf16*)(lds + P_KB + (cur) * (64 * RQP * 2)); const LAS bf16* Vc = (const LAS bf16*)(lds + P_VB + (cur) * (64 * P_VP * 2)); \
        const LAS bf16* STp = (const LAS bf16*)(lds + P_ST + ((cur) ^ 1) * (32 * RQP * 2)); \
        bf16x8 bv[2][2], sb[4]; \
        _Pragma("unroll") for (int ks = 0; ks < 2; ++ks) _Pragma("unroll") for (int et = 0; et < 2; ++et) bv[ks][et] = tr_frag(Vc + (ks * 32 + 8 * fq + tq) * P_VP + et * 16 + 4 * tp, P_VP); \
        _Pragma("unroll") for (int a = 0; a < 2; ++a) _Pragma("unroll") for (int b = 0; b < 2; ++b) S[a][b] = S[a][b] * gL; \
        _Pragma("unroll") for (int ks = 0; ks < 2; ++ks) { bf16x8 ak[2]; \
          _Pragma("unroll") for (int dti = 0; dti < 2; ++dti) ak[dti] = tr_frag(Kc + (ks * 32 + 8 * fq + tq) * RQP + (2 * wave + dti) * 16 + 4 * tp, RQP); \
          _Pragma("unroll") for (int dti = 0; dti < 2; ++dti) _Pragma("unroll") for (int et = 0; et < 2; ++et) S[dti][et] = MFMA16(ak[dti], bv[ks][et], S[dti][et]); } \
        RP_STOREST(cur); \
        {   \
          const f32x4 opart = *(const LAS f32x4*)(xo + ((cur) ^ 1) * 8192 + xrd); \
          { const f32x4 o = ocar + opart; u32x2 w; w.x = pk2(o[0], o[1]); w.y = pk2(o[2], o[3]);     \
            *(u32x2*)(obase + (size_t)((c) > 0 ? (c) - 1 : 0) * (64 * 512 * 2) + ooff) = w; } \
          f32x4 om = (f32x4){0.f, 0.f, 0.f, 0.f}, ot = om; \
          _Pragma("unroll") for (int ks = 0; ks < 4; ++ks) { sb[ks] = *(const LAS bf16x8*)(STp + (et_o * 16 + fr) * RQP + (et_o * 4 + ks) * 32 + fq * 8); } \
          _Pragma("unroll") for (int ks = 0; ks < 4; ++ks) om = MFMA16(sb[ks], qX[ks], om); \
          _Pragma("unroll") for (int ks = 0; ks < 4; ++ks) { sb[ks] = *(const LAS bf16x8*)(STp + ((et_o ^ 1) * 16 + fr) * RQP + (et_o * 4 + ks) * 32 + fq * 8); } \
          { const bf16x8 bm = tr_frag(Vc + (et_o * 32 + 8 * fq + tq) * P_VP + et_o * 16 + 4 * tp, P_VP), bt = tr_frag(Vc + (et_o * 32 + 8 * fq + tq) * P_VP + (et_o ^ 1) * 16 + 4 * tp, P_VP); \
            om = MFMA16(bm, pX[0], om); ot = MFMA16(bt, pX[0], ot); } \
          _Pragma("unroll") for (int ks = 0; ks < 4; ++ks) ot = MFMA16(sb[ks], qX[ks], ot); \
          ocar = om; *(LAS f32x4*)(xo + (cur) * 8192 + xwr) = ot; } \
        if (VAR != 1) { const int cq = (c) + 2 < NCH ? (c) + 2 : NCH - 1; RP_LOADQP(qX, pX, cq); } \
        } while (0)
    __syncthreads();
    RP_LOADKV(rkA, rvA, 0); RP_STOREKV(rkA, rvA, 0); RP_STOREST(1);
    RP_LOADKV(rkA, rvA, 1); RP_LOADKV(rkB, rvB, 2); RP_LOADQP(qA, pA, 0); RP_LOADQP(qB, pB, 1);
#pragma nounroll
    for (int c = 0; c < NCH; c += 2) {
        RP_BODY(c, 0, rkA, rvA, qA, pA);
        __builtin_amdgcn_sched_barrier(0);
        RP_BODY(c + 1, 1, rkB, rvB, qB, pB);
        __builtin_amdgcn_sched_barrier(0);
    }
#undef RP_BODY
    asm volatile("s_waitcnt lgkmcnt(0)" ::: "memory"); __builtin_amdgcn_s_barrier(); asm volatile("" ::: "memory");
    { const f32x4 opart = *(const LAS f32x4*)(xo + ((NCH - 1) & 1) * 8192 + xrd); const f32x4 o = ocar + opart; u32x2 w; w.x = pk2(o[0], o[1]); w.y = pk2(o[2], o[3]);
      *(u32x2*)(obase + (size_t)(NCH - 1) * (64 * 512 * 2) + ooff) = w; }
#undef RP_LOADKV
#undef RP_STOREKV
#undef RP_LOADQP
#undef RP_STOREST
#pragma unroll
    for (int dti = 0; dti < 2; ++dti)
#pragma unroll
        for (int et = 0; et < 2; ++et)
#pragma unroll
            for (int r = 0; r < 4; ++r) Sout[(size_t)((2 * wave + dti) * 16 + 4 * fq + r) * 512 + e0 + et * 16 + fr] = S[dti][et][r];
}
__device__ __forceinline__ void ph_retention(const float* const* in, unsigned char* ws, float* out, LAS unsigned char* lds) {
    const bf16* Q = (const bf16*)(ws + WS_R + R_Q); const bf16* K = (const bf16*)(ws + WS_R + R_K); const bf16* V = (const bf16*)(ws + WS_R + R_VV); bf16* O = (bf16*)(ws + WS_R + R_O);
#if DUP_PHASE >= 200
    for (int task = blockIdx.x; task < 256; task += gridDim.x) {
        const int xcd = task & 7, idx = task >> 3, bh = xcd * 2 + (idx >> 4), sl = idx & 15, b = bh >> 3, h = bh & 7;
        ret_prompt<DUP_PHASE - 200>(Q, K, V, (const bf16*)(ws + WS_PP) + ((size_t)(b * 128) * 8 + h) * 4096, (bf16*)(ws + WS_H) - (size_t)bh * SEQ * 512, bh * SEQ, h, sl * 32, (float*)(ws + WS_H + (16u << 20)), lds);
    }
    __syncthreads();
#endif
    for (int task = blockIdx.x; task < 256; task += gridDim.x) {
        const int xcd = task & 7, idx = task >> 3, bh = xcd * 2 + (idx >> 4), sl = idx & 15, b = bh >> 3, h = bh & 7;
        ret_prompt<0>(Q, K, V, (const bf16*)(ws + WS_PP) + ((size_t)(b * 128) * 8 + h) * 4096, O, bh * SEQ, h, sl * 32, out + OUT_RETP + (size_t)bh * 256 * 512, lds);
    }
#if DUP_PHASE == 111
    for (int rep_ = 0; rep_ < 2; ++rep_)
#endif
    for (int task = blockIdx.x; task < 256; task += gridDim.x) {
        const int su = task >> 1, sb = su >> 3, h = su & 7;
        for (int sl = (task & 1) * 4; sl < (task & 1) * 4 + 4; ++sl)
            ret_unit<32>(Q, K, V, (const bf16*)(ws + WS_PS) + (size_t)su * 1024, 0, O, MP * 8 + su * 32, 1, h, sl * 64, in[5] + (size_t)su * 256 * 512, out + OUT_RETS + (size_t)su * 256 * 512, lds);
    }
}
__device__ __forceinline__ void ph_gate_norm(unsigned char* ws) {
    const int lane = threadIdx.x & 63, gw = blockIdx.x * 8 + (threadIdx.x >> 6), ngw = gridDim.x * 8;
    bf16* G = (bf16*)(ws + WS_R + R_G); const bf16* O = (const bf16*)(ws + WS_R + R_O);
    for (int row = gw; row < M; row += ngw) {
#pragma unroll
        for (int hh = 0; hh < 8; ++hh) {
            const size_t off = (size_t)row * VW + hh * 512 + lane * 8, ooff = (size_t)hm_row(row, hh) * 512 + lane * 8;
            float o[8], g[8]; unpack8(*(const u32x4*)(O + ooff), o); unpack8(*(const u32x4*)(G + off), g);
            float s = 0.f;
#pragma unroll
            for (int j = 0; j < 8; ++j) s += o[j] * o[j];
            const float r = 1.0f / sqrtf(wave_sum(s) * (1.0f / 512.0f) + EPS);
#pragma unroll
            for (int j = 0; j < 8; ++j) g[j] = g[j] * o[j] * r;
            *(u32x4*)(G + off) = pack8(g);
        }
    }
}

#define XB_TMO      128
#define XB_XCNT(j)  (256  + 64 * (j))
#define XB_XSUB(j)  (1280 + 64 * (j))
#define XB_XGEN(j)  (2304 + 64 * (j))
#define XB_TOP      3328
#define XB_TOPGEN   3392
#define XCD_BAR_WORDS 3456
#define XB_SPIN_CAP (1u << 18)

__device__ __forceinline__ unsigned xb_ld(unsigned* p)              { return __hip_atomic_load(p, __ATOMIC_RELAXED, __HIP_MEMORY_SCOPE_AGENT); }
__device__ __forceinline__ unsigned xb_add(unsigned* p, unsigned v) { return __hip_atomic_fetch_add(p, v, __ATOMIC_RELAXED, __HIP_MEMORY_SCOPE_AGENT); }
__device__ __forceinline__ unsigned xb_xcc_id() { return (unsigned)__builtin_amdgcn_s_getreg((3 << 11) | 20) & 0xFu; }
#define XB_SPIN(cond, bar) do { unsigned _sp = 0; while (cond) { __builtin_amdgcn_s_sleep(1); \
    if ((++_sp & 255u) == 0u) { if (xb_ld(&(bar)[XB_TMO])) break; if (_sp > XB_SPIN_CAP) { atomicAdd(&(bar)[XB_TMO], 1u); break; } } } } while (0)

struct XcdBarrier {
    unsigned* bar; unsigned x;
    volatile LAS unsigned* st;
};

__device__ __forceinline__ XcdBarrier xcd_barrier_post(unsigned* bar, volatile LAS unsigned* st) {
    XcdBarrier b; b.bar = bar; b.x = xb_xcc_id(); b.st = st;
    if (threadIdx.x == 0) (void)xb_add(&bar[XB_XCNT(b.x)], 1u);
    return b;
}
__device__ __forceinline__ void xcd_barrier_complete(unsigned* bar, unsigned x, unsigned& nloc, unsigned& nx) {
    const unsigned G = gridDim.x * gridDim.y * gridDim.z;
    unsigned sum, cnt, mine, sp = 0u;
    for (;;) {
        sum = 0u; cnt = 0u; mine = 0u;
#pragma unroll
        for (unsigned j = 0; j < 16; ++j) { const unsigned c = xb_ld(&bar[XB_XCNT(j)]); sum += c; cnt += (c > 0u) ? 1u : 0u; mine = (j == x) ? c : mine; }
        if (sum == G) break;
        __builtin_amdgcn_s_sleep(1);
        if ((++sp & 255u) == 0u) { if (xb_ld(&bar[XB_TMO])) break; if (sp > XB_SPIN_CAP) { atomicAdd(&bar[XB_TMO], 1u); break; } }
    }
    nloc = mine > 0u ? mine : 1u; nx = cnt > 0u ? cnt : 1u;
}

__device__ __forceinline__ void xcd_barrier(const XcdBarrier& b) {
    asm volatile("s_waitcnt vmcnt(0)" ::: "memory");
    __syncthreads();
    if (threadIdx.x == 0) {
        unsigned* bar = b.bar;
        __builtin_amdgcn_s_waitcnt(0);
        unsigned nloc = b.st[0], nx = b.st[1];
        if (nloc == 0u) { xcd_barrier_complete(bar, b.x, nloc, nx); b.st[0] = nloc; b.st[1] = nx; }
        const unsigned old = xb_add(&bar[XB_XSUB(b.x)], 1u);
        const unsigned gen = old / nloc;
        if (old + 1u == (gen + 1u) * nloc) {
            __builtin_amdgcn_fence(__ATOMIC_RELEASE, "agent");
            asm volatile("s_waitcnt vmcnt(0)" ::: "memory");
            const unsigned og = xb_add(&bar[XB_TOP], 1u);
            const unsigned tg = og / nx;
            if (og + 1u == (tg + 1u) * nx) xb_add(&bar[XB_TOPGEN], 1u);
            else XB_SPIN(xb_ld(&bar[XB_TOPGEN]) == tg, bar);
            __builtin_amdgcn_fence(__ATOMIC_ACQUIRE, "agent");
            xb_add(&bar[XB_XGEN(b.x)], 1u);
            asm volatile("s_waitcnt vmcnt(0)" ::: "memory");
        } else {
            XB_SPIN(xb_ld(&bar[XB_XGEN(b.x)]) == gen, bar);
            __builtin_amdgcn_fence(__ATOMIC_ACQUIRE, "agent");
            asm volatile("s_waitcnt vmcnt(0)" ::: "memory");
        }
    }
    __syncthreads();
}

struct Args { const float* in[23]; float* out; unsigned char* ws; int ph_lo, ph_hi; };
static_assert(sizeof(Args) == 23 * 8 + 8 + 8 + 8, "Args has no padding");

#ifndef WGM_A
#define WGM_A 4
#endif
#ifndef WGM_B
#define WGM_B 4
#endif
#ifndef WGM_C
#define WGM_C 4
#endif
template <class Epi> __device__ __forceinline__ void run_gemm(LAS unsigned char* lds, const bf16* A, const bf16* Bt, int N, int K, const Epi& E) {
    pg8::Gemm g{A, Bt, M, N, K, K}; pg8::StaticOrder S; S.init(M, N, (int)gridDim.x, (int)blockIdx.x, N == 3072 ? WGM_A : WGM_B);
    pg8::gemm_phase<Epi, pg8::StaticOrder, true, true>(lds, g, S, E);
}
__device__ __forceinline__ void run_gemm_res(LAS unsigned char* lds, const bf16* A, const bf16* Bt, int K, const EpiRes& E, float* PART, int KS) {
    { pg8::Gemm g{A, Bt, MP, D, K, K}; pg8::StaticOrder S; S.init(MP, D, (int)gridDim.x, (int)blockIdx.x, WGM_C);
      pg8::gemm_phase<EpiRes, pg8::StaticOrder, true, true>(lds, g, S, E); }
    { const int KL = K / KS; pg8::Gemm g{A, Bt, M, D, K, KL}; SplitOrder S{D / 256, KS, KL, (int)gridDim.x, (int)blockIdx.x}; EpiPartial EP{PART, KL};
      pg8::gemm_phase<EpiPartial, SplitOrder, true, true>(lds, g, S, EP); }
}

__global__ void __launch_bounds__(512, 2) mega_fwd(Args a) {
    extern __shared__ __attribute__((aligned(16))) unsigned char lds_raw[];
    LAS unsigned char* lds = (LAS unsigned char*)lds_raw;
    cg::grid_group grid = cg::this_grid();
    unsigned char* ws = a.ws; float* out = a.out;
    const int lo = a.ph_lo, hi = a.ph_hi;
#define IN(k) (lo <= (k) && (k) < hi)
#ifndef DUP_PHASE
#define DUP_PHASE -1
#endif
#define SEAM(k) do { if (IN(k) && IN((k) + 1)) { if (lo < 0) { asm volatile("s_waitcnt vmcnt(0) lgkmcnt(0)" ::: "memory"); grid.sync(); } else xcd_barrier(xbar); } } while (0)
    volatile LAS unsigned* xst = (volatile LAS unsigned*)(lds + LDS_BYTES);
    if (threadIdx.x < 2) xst[threadIdx.x] = 0u;
    __syncthreads();
    XcdBarrier xbar = xcd_barrier_post((unsigned*)(ws + WS_BAR), xst);
    float* mods = (float*)(ws + WS_MODS);
    bf16* H = (bf16*)(ws + WS_H);
    unsigned char* wb = ws + WS_W; unsigned char* R = ws + WS_R;
    float* X = out + OUT_Y;
    float* PART = (float*)(R + R_O);
    constexpr int KS2 = 8, KS4 = 8, KS5 = 11;

    if (IN(0)) ph_prologue(a.in, ws, lds);
#if DUP_PHASE == 0
    __syncthreads();
    if (IN(0)) ph_prologue(a.in, ws, lds);
#endif
    SEAM(0);
    if (IN(1)) ph_norm(a.in[0], a.in[1], a.in[8], mods + 0 * D, mods + 1 * D, H, nullptr, 0, nullptr, nullptr);
#if DUP_PHASE == 1
    __syncthreads();
    if (IN(1)) ph_norm(a.in[0], a.in[1], a.in[8], mods + 0 * D, mods + 1 * D, H, nullptr, 0, nullptr, nullptr);
#endif
    SEAM(1);
    if (IN(2)) { EpiInAB E{(bf16*)(R + R_U), (bf16*)(R + R_V), (bf16*)(R + R_XB), out + OUT_POOLP, out + OUT_POOLS};
        run_gemm(lds, H, (const bf16*)(wb + W0_IN), 3072, D, E); }
#if DUP_PHASE == 2
    __syncthreads();
    if (IN(2)) { EpiInAB E{(bf16*)(R + R_U), (bf16*)(R + R_V), (bf16*)(R + R_XB), out + OUT_POOLP, out + OUT_POOLS};
        run_gemm(lds, H, (const bf16*)(wb + W0_IN), 3072, D, E); }
#endif
    SEAM(2);
    if (IN(3)) ph_mixer(a.in, ws, out, lds);
#if DUP_PHASE == 3
    __syncthreads();
    if (IN(3)) ph_mixer(a.in, ws, out, lds);
#endif
    SEAM(3);
    if (IN(4)) { EpiRes E{a.in[0], a.in[1], X, mods + 2 * D}; run_gemm_res(lds, H, (const bf16*)(wb + W0_OUT), D, E, PART, KS2); }
    SEAM(4);
    if (IN(5)) ph_norm(X, a.in[1], a.in[9], mods + 3 * D, mods + 4 * D, H, PART, KS2, mods + 2 * D, X);
    SEAM(5);
    if (IN(6)) { EpiSwiGLU E{(bf16*)(R + R_ACT)}; run_gemm(lds, H, (const bf16*)(wb + W0_GU), 2 * DFF, D, E); }
#if DUP_PHASE == 6
    __syncthreads();
    if (IN(6)) { EpiSwiGLU E{(bf16*)(R + R_ACT)}; run_gemm(lds, H, (const bf16*)(wb + W0_GU), 2 * DFF, D, E); }
#endif
    SEAM(6);
    if (IN(7)) { EpiRes E{X, X + (size_t)MP * D, X, mods + 5 * D}; run_gemm_res(lds, (const bf16*)(R + R_ACT), (const bf16*)(wb + W0_DN), DFF, E, PART, KS5); }
    SEAM(7);
    if (IN(8)) {
        ph_norm(X, X + (size_t)MP * D, a.in[8] + D, mods + (size_t)NBI * NMOD + 0 * D, mods + (size_t)NBI * NMOD + 1 * D, H, PART, KS5, mods + 5 * D, X);
        __syncthreads();
        const int lane = threadIdx.x & 63, wave = threadIdx.x >> 6; LAS float* scr = (LAS float*)(lds + wave * 16384);
        const int gw = blockIdx.x * 8 + wave, ngw = gridDim.x * 8;
        convert_weight(a.in[19], D, NQKVG, (bf16*)(wb + W1_IN), 0, scr, lane, gw, ngw);
        convert_weight(a.in[20], VW, D, (bf16*)(wb + W1_OUT), 0, scr, lane, gw, ngw);
        convert_weight(a.in[21] + (size_t)D * 2 * DFF, D, 2 * DFF, (bf16*)(wb + W1_GU), 1, scr, lane, gw, ngw);
        convert_weight(a.in[22] + (size_t)DFF * D, DFF, D, (bf16*)(wb + W1_DN), 0, scr, lane, gw, ngw);
    }
    SEAM(8);
    if (IN(9)) { EpiQKVG E{(bf16*)(R + R_Q), (bf16*)(R + R_K), (bf16*)(R + R_VV), (bf16*)(R + R_G), (const float*)(ws + WS_COS), (const float*)(ws + WS_SIN)};
        run_gemm(lds, H, (const bf16*)(wb + W1_IN), NQKVG, D, E); }
#if DUP_PHASE == 9
    __syncthreads();
    if (IN(9)) { EpiQKVG E{(bf16*)(R + R_Q), (bf16*)(R + R_K), (bf16*)(R + R_VV), (bf16*)(R + R_G), (const float*)(ws + WS_COS), (const float*)(ws + WS_SIN)};
        run_gemm(lds, H, (const bf16*)(wb + W1_IN), NQKVG, D, E); }
#endif
    SEAM(9);
    if (IN(10)) ph_scores(ws);
#if DUP_PHASE == 10
    __syncthreads();
    if (IN(10)) ph_scores(ws);
#endif
    SEAM(10);
    if (IN(11)) ph_retention(a.in, ws, out, lds);
#if DUP_PHASE == 11
    __syncthreads();
    if (IN(11)) ph_retention(a.in, ws, out, lds);
#endif
    SEAM(11);
    if (IN(12)) ph_gate_norm(ws);
    SEAM(12);
    if (IN(13)) { EpiRes E{X, X + (size_t)MP * D, X, mods + (size_t)NBI * NMOD + 2 * D}; run_gemm_res(lds, (const bf16*)(R + R_G), (const bf16*)(wb + W1_OUT), VW, E, PART, KS4); }
    SEAM(13);
    if (IN(14)) ph_norm(X, X + (size_t)MP * D, a.in[9] + D, mods + (size_t)NBI * NMOD + 3 * D, mods + (size_t)NBI * NMOD + 4 * D, H, PART, KS4, mods + (size_t)NBI * NMOD + 2 * D, X);
    SEAM(14);
    if (IN(15)) { EpiSwiGLU E{(bf16*)(R + R_ACT)}; run_gemm(lds, H, (const bf16*)(wb + W1_GU), 2 * DFF, D, E); }
    SEAM(15);
    if (IN(16)) { EpiRes E{X, X + (size_t)MP * D, X, mods + (size_t)NBI * NMOD + 5 * D}; run_gemm_res(lds, (const bf16*)(R + R_ACT), (const bf16*)(wb + W1_DN), DFF, E, PART, KS5); }
    SEAM(16);
    if (IN(17)) ph_final_norm(X, a.in[10], PART, KS5, mods + (size_t)NBI * NMOD + 5 * D);
#undef IN
#undef SEAM
}

#ifndef N_PHASES_RUN
#define N_PHASES_RUN 18
#endif
extern "C" void kernel_launch(void* const* d_in, const int* in_sizes, int n_in, void* d_out, int out_size, void* d_ws, size_t ws_size, hipStream_t stream) {
    static int grid = 0;
    if (grid == 0) {
        if (n_in != 23 || ws_size < WS_END) { fprintf(stderr, "kernel_launch: unexpected n_in %d / ws_size %zu (need %zu)\n", n_in, ws_size, (size_t)WS_END); grid = -1; return; }
        int dev = 0, cus = 0, per_cu = 0;
        hipGetDevice(&dev); hipDeviceGetAttribute(&cus, hipDeviceAttributeMultiprocessorCount, dev);
        if (hipFuncSetAttribute((const void*)mega_fwd, hipFuncAttributeMaxDynamicSharedMemorySize, LDS_BYTES + 256) != hipSuccess) { fprintf(stderr, "kernel_launch: hipFuncSetAttribute failed\n"); grid = -1; return; }
        if (hipOccupancyMaxActiveBlocksPerMultiprocessor(&per_cu, (const void*)mega_fwd, 512, LDS_BYTES + 256) != hipSuccess || per_cu < 1) per_cu = 1;
        (void)hipGetLastError();
        grid = cus * per_cu;
    }
    if (grid < 0) return;
    Args a{};
    for (int i = 0; i < 23; ++i) a.in[i] = (const float*)d_in[i];
    a.out = (float*)d_out; a.ws = (unsigned char*)d_ws; a.ph_lo = 0; a.ph_hi = N_PHASES_RUN;
    if (hipMemsetAsync((char*)d_ws + WS_BAR, 0, XCD_BAR_WORDS * 4, stream) != hipSuccess) { fprintf(stderr, "kernel_launch: memset failed\n"); return; }
    void* args[] = {&a};
    hipError_t e = hipLaunchCooperativeKernel((const void*)mega_fwd, dim3(grid), dim3(512), args, LDS_BYTES + 256, stream);
    if (e != hipSuccess) fprintf(stderr, "kernel_launch: cooperative launch failed: %s (grid %d)\n", hipGetErrorString(e), grid);
}
```
